# Optimizing an MI355X kernel written in HIP

```python
import math
import jax, jax.numpy as jnp
from jax import lax
import numpy as np


D_MODEL = 2048
BATCH = 4
SEQ = 2048
DEPTH = 1

MEM_LEN = 256
ML_HEADS = 4
ML_QK = 256
ML_V = 512
ML_CHUNK = 64
CONV_W = 4
ML_QK_W = ML_HEADS * ML_QK
ML_V_W = ML_HEADS * ML_V
FOX_HEADS = 16
FOX_HD = 128
FOX_W = FOX_HEADS * FOX_HD
Q_BLOCK = 128
X_HEADS = 4
X_HD = D_MODEL // X_HEADS
PEER_HEADS = 8
N_KEYS = 128
N_EXPERTS = N_KEYS * N_KEYS
PEER_DK = 256
PEER_TOPK = 16
PEER_TOK_BLOCK = 128
LN_EPS = 1e-5
DN_ALPHA = (2 * DEPTH) ** 0.25
DN_BETA = (8 * DEPTH) ** -0.25
SPLIT_SIZES = (ML_QK_W, ML_QK_W, ML_V_W, ML_V_W, ML_HEADS, ML_HEADS,
               FOX_W, FOX_W, FOX_W, FOX_HEADS, D_MODEL, D_MODEL)
IN_PROJ_W = sum(SPLIT_SIZES)

kernel_name = 'hybrid_mlstm_fox_peer_deepnorm'

F32 = jnp.float32


def layer_norm(x, w, b):
    xf = x.astype(F32)
    mu = jnp.mean(xf, -1, keepdims=True)
    var = jnp.mean(jnp.square(xf - mu), -1, keepdims=True)
    return ((xf - mu) * lax.rsqrt(var + LN_EPS) * w.astype(F32) + b.astype(F32)).astype(x.dtype)


def _heads(t, n):
    B, S, _ = t.shape
    return t.reshape(B, S, n, -1).transpose(0, 2, 1, 3)


def causal_dwconv(x, w, b):
    C = x.shape[-1]
    y = lax.conv_general_dilated(x, w[:, None, :].astype(x.dtype), window_strides=(1,),
                                 padding=((CONV_W - 1, 0),), dimension_numbers=('NWC', 'WIO', 'NWC'),
                                 feature_group_count=C)
    return y + b.astype(x.dtype)


def mlstm_chunkwise(q, k, v, i_pre, f_pre):
    B, H, S, dk = q.shape
    dv = v.shape[-1]
    L = ML_CHUNK
    nc = S // L
    q = q.astype(F32).reshape(B, H, nc, L, dk)
    k = (k.astype(F32) * dk ** -0.5).reshape(B, H, nc, L, dk)
    v = v.astype(F32).reshape(B, H, nc, L, dv)
    ig = i_pre.reshape(B, H, nc, L)
    b = jnp.cumsum(jax.nn.log_sigmoid(f_pre).reshape(B, H, nc, L), -1)
    b_last = b[..., -1]
    w_end = b_last[..., None] - b + ig
    m_end_intra = jnp.max(w_end, -1)

    def step(carry, inp):
        C, n, m = carry
        k_c, v_c, w_c, bl_c, mi_c = inp
        m_new = jnp.maximum(bl_c + m, mi_c)
        decay = jnp.exp(bl_c + m - m_new)
        wk = jnp.exp(w_c - m_new[..., None])[..., None] * k_c
        C_new = decay[..., None, None] * C + jnp.einsum('bhld,bhle->bhde', wk, v_c)
        n_new = decay[..., None] * n + jnp.sum(wk, -2)
        return (C_new, n_new, m_new), (C, n, m)

    init = (jnp.zeros((B, H, dk, dv), F32), jnp.zeros((B, H, dk), F32), jnp.zeros((B, H), F32))
    xs = (jnp.moveaxis(k, 2, 0), jnp.moveaxis(v, 2, 0), jnp.moveaxis(w_end, 2, 0),
          jnp.moveaxis(b_last, 2, 0), jnp.moveaxis(m_end_intra, 2, 0))
    _, (C_prev, n_prev, m_prev) = lax.scan(step, init, xs)
    C_prev = jnp.moveaxis(C_prev, 0, 2)
    n_prev = jnp.moveaxis(n_prev, 0, 2)
    m_prev = jnp.moveaxis(m_prev, 0, 2)

    causal = jnp.tril(jnp.ones((L, L), dtype=bool))
    Dlog = jnp.where(causal, b[..., :, None] - b[..., None, :] + ig[..., None, :], -jnp.inf)
    a = b + m_prev[..., None]
    m_t = jnp.maximum(a, jnp.max(Dlog, -1))
    P = jnp.exp(Dlog - m_t[..., None]) * jnp.einsum('bhctd,bhcsd->bhcts', q, k)
    inter = jnp.exp(a - m_t)
    num = jnp.einsum('bhcts,bhcse->bhcte', P, v) + inter[..., None] * jnp.einsum('bhctd,bhcde->bhcte', q, C_prev)
    den = jnp.sum(P, -1) + inter * jnp.einsum('bhctd,bhcd->bhct', q, n_prev)
    h = num / jnp.maximum(jnp.abs(den), jnp.exp(-m_t))[..., None]
    return h.reshape(B, H, S, dv)


def forgetting_attention(q, k, v, f_pre):
    B, H, S, d = q.shape
    F = jnp.cumsum(jax.nn.log_sigmoid(f_pre), -1)
    nb = S // Q_BLOCK
    qb = q.reshape(B, H, nb, Q_BLOCK, d).transpose(2, 0, 1, 3, 4)
    Fqb = F.reshape(B, H, nb, Q_BLOCK).transpose(2, 0, 1, 3)
    pos_k = jnp.arange(S)
    scale = d ** -0.5

    def block(args):
        qi, Fi, start = args
        s = jnp.einsum('bhqd,bhkd->bhqk', qi, k, preferred_element_type=F32) * scale
        s = s + Fi[..., :, None] - F[..., None, :]
        pos_q = start + jnp.arange(Q_BLOCK)
        s = jnp.where(pos_k[None, :] <= pos_q[:, None], s, -jnp.inf)
        p = jax.nn.softmax(s, -1)
        return jnp.einsum('bhqk,bhkd->bhqd', p.astype(v.dtype), v)

    out = lax.map(block, (qb, Fqb, jnp.arange(nb) * Q_BLOCK))
    return out.transpose(1, 2, 0, 3, 4).reshape(B, H, S, d)


def hybrid_mixer(x, w_in, conv_w, conv_b, gate_b, norm_w, fox_f_b, w_br_ml, w_br_fox, w_out):
    B, S, _ = x.shape
    cuts = [int(c) for c in np.cumsum(SPLIT_SIZES)[:-1]]
    (ml_q, ml_k, ml_v, ml_o, ml_i, ml_f,
     fx_q, fx_k, fx_v, fx_f, g_ml, g_fx) = jnp.split(x @ w_in, cuts, axis=-1)
    qk = jax.nn.silu(causal_dwconv(jnp.concatenate([ml_q, ml_k], -1), conv_w, conv_b))
    ml_q, ml_k = qk[..., :ML_QK_W], qk[..., ML_QK_W:]
    i_pre = (ml_i.astype(F32) + gate_b[0].astype(F32)).transpose(0, 2, 1)
    f_pre = (ml_f.astype(F32) + gate_b[1].astype(F32)).transpose(0, 2, 1)
    h = mlstm_chunkwise(_heads(ml_q, ML_HEADS), _heads(ml_k, ML_HEADS), _heads(ml_v, ML_HEADS), i_pre, f_pre)
    mu = jnp.mean(h, -1, keepdims=True)
    var = jnp.mean(jnp.square(h - mu), -1, keepdims=True)
    h = (h - mu) * lax.rsqrt(var + LN_EPS) * norm_w.astype(F32).reshape(ML_HEADS, 1, ML_V)
    h = h.transpose(0, 2, 1, 3).reshape(B, S, ML_V_W).astype(x.dtype) * jax.nn.sigmoid(ml_o)
    fox_f_pre = (fx_f.astype(F32) + fox_f_b.astype(F32)).transpose(0, 2, 1)
    y = forgetting_attention(_heads(fx_q, FOX_HEADS), _heads(fx_k, FOX_HEADS), _heads(fx_v, FOX_HEADS), fox_f_pre)
    y = y.transpose(0, 2, 1, 3).reshape(B, S, FOX_W)
    merged = jax.nn.sigmoid(g_ml) * (h @ w_br_ml) + jax.nn.sigmoid(g_fx) * (y @ w_br_fox)
    return merged @ w_out


def memory_cross_attention(x, mem, w_q, w_kv, w_o):
    B, S, _ = x.shape
    q = (x @ w_q).reshape(B, S, X_HEADS, X_HD)
    kv = mem @ w_kv
    k = kv[..., :D_MODEL].reshape(B, -1, X_HEADS, X_HD)
    v = kv[..., D_MODEL:].reshape(B, -1, X_HEADS, X_HD)
    s = jnp.einsum('bshd,bmhd->bhsm', q, k, preferred_element_type=F32) * X_HD ** -0.5
    p = jax.nn.softmax(s, -1)
    o = jnp.einsum('bhsm,bmhd->bshd', p.astype(v.dtype), v).reshape(B, S, D_MODEL)
    return o @ w_o


def peer_ffn(x, w_pq, sub_keys, expert_u, expert_v):
    B, S, D = x.shape
    q = (x @ w_pq).reshape(B, S, PEER_HEADS, 2, PEER_DK // 2)
    sc = jnp.einsum('bshpd,hpnd->bshpn', q, sub_keys, preferred_element_type=F32)
    top_s, top_i = lax.top_k(sc, PEER_TOPK)
    cand_s = (top_s[..., 0, :, None] + top_s[..., 1, None, :]).reshape(B, S, PEER_HEADS, PEER_TOPK * PEER_TOPK)
    cand_i = (top_i[..., 0, :, None] * N_KEYS + top_i[..., 1, None, :]).reshape(B, S, PEER_HEADS, PEER_TOPK * PEER_TOPK)
    best_s, best_pos = lax.top_k(cand_s, PEER_TOPK)
    idx = jnp.take_along_axis(cand_i, best_pos, -1)
    g = jax.nn.softmax(best_s, -1)
    nblk = (B * S) // PEER_TOK_BLOCK
    HK = PEER_HEADS * PEER_TOPK
    xb = x.reshape(nblk, PEER_TOK_BLOCK, D)
    ib = idx.reshape(nblk, PEER_TOK_BLOCK, HK)
    gb = g.reshape(nblk, PEER_TOK_BLOCK, HK)

    def block(args):
        xt, it, gt = args
        u = expert_u[it]
        a = jnp.einsum('tkd,td->tk', u, xt, preferred_element_type=F32)
        hact = jax.nn.gelu(a, approximate=False) * gt
        return jnp.einsum('tk,tkd->td', hact.astype(x.dtype), expert_v[it])

    return lax.map(block, (xb, ib, gb)).reshape(B, S, D)


def setup_inputs(seed: int = 0) -> dict:
    key = jax.random.key(seed)
    ks = jax.random.split(key, 24)
    nrm = lambda k, shape, s: jax.random.normal(k, shape, F32) * s
    dinv = D_MODEL ** -0.5
    gate_b = jnp.stack([nrm(ks[5], (DEPTH, ML_HEADS), 0.1),
                        jnp.linspace(3.0, 6.0, ML_HEADS)[None, :] + nrm(ks[6], (DEPTH, ML_HEADS), 0.1)], axis=1)
    return {
        'x': jax.random.normal(ks[0], (BATCH, SEQ, D_MODEL), F32),
        'mem': jax.random.normal(ks[1], (BATCH, MEM_LEN, D_MODEL), F32),
        'w_in': nrm(ks[2], (DEPTH, D_MODEL, IN_PROJ_W), dinv),
        'ml_conv_w': nrm(ks[3], (DEPTH, CONV_W, 2 * ML_QK_W), CONV_W ** -0.5),
        'ml_conv_b': nrm(ks[4], (DEPTH, 2 * ML_QK_W), 0.02),
        'ml_gate_b': gate_b,
        'ml_norm_w': 1.0 + nrm(ks[7], (DEPTH, ML_V_W), 0.02),
        'fox_f_b': jnp.linspace(1.0, 4.0, FOX_HEADS)[None, :] + nrm(ks[8], (DEPTH, FOX_HEADS), 0.1),
        'w_branch_ml': nrm(ks[9], (DEPTH, ML_V_W, D_MODEL), ML_V_W ** -0.5 * DN_BETA),
        'w_branch_fox': nrm(ks[10], (DEPTH, FOX_W, D_MODEL), FOX_W ** -0.5 * DN_BETA),
        'w_out': nrm(ks[11], (DEPTH, D_MODEL, D_MODEL), dinv * DN_BETA),
        'w_xq': nrm(ks[12], (DEPTH, D_MODEL, D_MODEL), dinv),
        'w_xkv': nrm(ks[13], (DEPTH, D_MODEL, 2 * D_MODEL), dinv),
        'w_xo': nrm(ks[14], (DEPTH, D_MODEL, D_MODEL), dinv * DN_BETA),
        'peer_wq': nrm(ks[15], (DEPTH, D_MODEL, PEER_HEADS * PEER_DK), dinv),
        'peer_sub_keys': nrm(ks[16], (DEPTH, PEER_HEADS, 2, N_KEYS, PEER_DK // 2), (PEER_DK // 2) ** -0.5),
        'peer_u': nrm(ks[17], (DEPTH, N_EXPERTS, D_MODEL), dinv),
        'peer_v': nrm(ks[18], (DEPTH, N_EXPERTS, D_MODEL), DN_BETA * PEER_HEADS ** -0.5),
        'ln_w': 1.0 + nrm(ks[19], (DEPTH, 3, D_MODEL), 0.02),
        'ln_b': nrm(ks[20], (DEPTH, 3, D_MODEL), 0.02),
    }


def reference(x, mem, w_in, ml_conv_w, ml_conv_b, ml_gate_b, ml_norm_w, fox_f_b, w_branch_ml, w_branch_fox,
              w_out, w_xq, w_xkv, w_xo, peer_wq, peer_sub_keys, peer_u, peer_v, ln_w, ln_b):
    for l in range(DEPTH):
        h = hybrid_mixer(x, w_in[l], ml_conv_w[l], ml_conv_b[l], ml_gate_b[l], ml_norm_w[l], fox_f_b[l],
                         w_branch_ml[l], w_branch_fox[l], w_out[l])
        x = layer_norm(DN_ALPHA * x + h, ln_w[l, 0], ln_b[l, 0])
        h = memory_cross_attention(x, mem, w_xq[l], w_xkv[l], w_xo[l])
        x = layer_norm(DN_ALPHA * x + h, ln_w[l, 1], ln_b[l, 1])
        h = peer_ffn(x, peer_wq[l], peer_sub_keys[l], peer_u[l], peer_v[l])
        x = layer_norm(DN_ALPHA * x + h, ln_w[l, 2], ln_b[l, 2])
    return x
```

```cpp
#include <hip/hip_runtime.h>
#include <hip/hip_cooperative_groups.h>
#include <cstdio>
namespace cg = cooperative_groups;

#define LAS __attribute__((address_space(3)))
typedef unsigned short bf16_t;
typedef short bf16x8 __attribute__((ext_vector_type(8)));
typedef float f32x4 __attribute__((ext_vector_type(4)));
typedef unsigned u32x4 __attribute__((ext_vector_type(4)));
typedef unsigned u32x2 __attribute__((ext_vector_type(2)));

constexpr int T_TOK = 8192, DM = 2048, SEQ = 2048, W_IN_LD = 16408;
constexpr int P1_LD = 12288;
constexpr float DN_ALPHA = 1.189207115002721f;
constexpr float LN_EPS = 1e-5f;
constexpr float MQ_SCALE = 64.0f, OQ_SCALE = 128.0f;
constexpr float XQ_SCALE = 32.0f, WQ_SCALE = 1024.0f;
constexpr size_t MiB = (size_t)1 << 20;
constexpr size_t OFF_P1 = 0, OFF_VT = 192 * MiB, OFF_UB = 0, OFF_VB = 64 * MiB, OFF_PRE = 128 * MiB, OFF_X1F = 192 * MiB, OFF_QP = 192 * MiB;
constexpr size_t OFF_XB = 256 * MiB, OFF_HPRE = 256 * MiB, OFF_X1B = 256 * MiB, OFF_X2B = 256 * MiB;
constexpr size_t OFF_WMAIN = 288 * MiB, OFF_YB = 288 * MiB, OFF_QX = 288 * MiB, OFF_HB = 320 * MiB, OFF_OB = 320 * MiB, OFF_WV = 336 * MiB;
constexpr size_t OFF_WSQ = 352 * MiB, OFF_WXKV = 400 * MiB, OFF_MEMB = 416 * MiB, OFF_T1 = 424 * MiB, OFF_X2F = 424 * MiB;
constexpr size_t OFF_MRG = 488 * MiB, OFF_QKC = 488 * MiB, OFF_IDX = 520 * MiB, OFF_G = 524 * MiB, OFF_KC = 528 * MiB, OFF_VCT = 532 * MiB;
constexpr size_t OFF_GATES = 536 * MiB, OFF_FOXF = 537 * MiB, OFF_MLB = 538 * MiB, OFF_MLMP = 538 * MiB + 256 * 1024, OFF_MLFC = 538 * MiB + 512 * 1024;
constexpr size_t OFF_CTL = 539 * MiB, WS_END = 540 * MiB;
constexpr size_t OFF_X1Q = OFF_T1;
constexpr int LDS_BYTES = 153 * 1024;
constexpr int NPHASE = 14;

struct Params {
    const float *x, *mem, *w_in, *conv_w, *conv_b, *gate_b, *norm_w, *fox_f_b;
    const float *w_sq[6];
    const float *w_xkv, *sub_keys, *peer_u, *peer_v, *ln_w, *ln_b;
    float* out; unsigned char* ws;
    int ph_lo, ph_hi, coop, pad;
};

__device__ __forceinline__ unsigned cvt_pk_bf16(float lo, float hi) { unsigned r; asm volatile("v_cvt_pk_bf16_f32 %0, %1, %2" : "=v"(r) : "v"(lo), "v"(hi)); return r; }
__device__ __forceinline__ float bflo(unsigned w) { return __uint_as_float(w << 16); }
__device__ __forceinline__ float bfhi(unsigned w) { return __uint_as_float(w & 0xffff0000u); }
__device__ __forceinline__ float wsum(float v) {
    v += __int_as_float(__builtin_amdgcn_update_dpp(0, __float_as_int(v), 0x111, 0xf, 0xf, true));
    v += __int_as_float(__builtin_amdgcn_update_dpp(0, __float_as_int(v), 0x112, 0xf, 0xf, true));
    v += __int_as_float(__builtin_amdgcn_update_dpp(0, __float_as_int(v), 0x114, 0xf, 0xf, true));
    v += __int_as_float(__builtin_amdgcn_update_dpp(0, __float_as_int(v), 0x118, 0xf, 0xf, true));
    v += __int_as_float(__builtin_amdgcn_update_dpp(0, __float_as_int(v), 0x142, 0xa, 0xf, false));
    v += __int_as_float(__builtin_amdgcn_update_dpp(0, __float_as_int(v), 0x143, 0xc, 0xf, false));
    return __int_as_float(__builtin_amdgcn_readlane(__float_as_int(v), 63)); }
__device__ __forceinline__ unsigned wmaxu(unsigned v) {
#pragma unroll
    for (int o = 32; o > 0; o >>= 1) { unsigned t = (unsigned)__shfl_xor((int)v, o); v = t > v ? t : v; }
    return v; }
__device__ __forceinline__ float clamp8(float x) { return fminf(fmaxf(x, -440.f), 440.f); }
__device__ __forceinline__ float sigmoidf_(float x) { return 1.0f / (1.0f + __expf(-x)); }
__device__ __forceinline__ float logsigf_(float z) { return fminf(z, 0.0f) - log1pf(expf(-fabsf(z))); }

namespace pg8 {
constexpr int BM = 256, BK = 64, HALF = 128, HTB = HALF * BK * 2, STAGE_BYTES = 8 * HTB, NXCD = 8, WGM = 8;
__device__ __forceinline__ int lds_byte(int r, int c) { const int st = (r >> 4) * 2 + (c >> 5), rr = r & 15, cc = c & 31, ob = rr * 64 + cc * 2; return st * 1024 + (ob ^ (((ob >> 9) & 1) << 5)); }
__device__ __forceinline__ void stage_rc(int b, int& R, int& C) { const int st = b / 1024, sb = b % 1024, swz = sb ^ (((sb >> 9) & 1) << 5); R = (st >> 1) * 16 + swz / 64; C = (st & 1) * 32 + (swz % 64) / 2; }
__device__ __forceinline__ int perm32(int rho) { const int n = rho >> 4, i = rho & 15; return 8 * (i >> 2) + 4 * n + (i & 3); }
struct Unit { int pm, pn, which; };
struct Gemm { const bf16_t* A[2]; const bf16_t* Bt[2]; int M[2], N[2]; int K, lda, ldb; int sca, scb; };
struct StaticOrder {
    int nM[2], nN[2], nwg[2], G, c;
    __device__ void init(const Gemm& g, int G_, int c_) { for (int i = 0; i < 2; ++i) { nM[i] = g.M[i] / BM; nN[i] = g.N[i] / BM; nwg[i] = nM[i] * nN[i]; } G = G_; c = c_; }
    __device__ bool next(int i, Unit& u) const {
        long L = (long)i * G + c; int w = 0;
        if (L >= nwg[0]) { L -= nwg[0]; w = 1; if (L >= nwg[1]) return false; }
        const int nwg_ = w ? nwg[1] : nwg[0], nM_ = w ? nM[1] : nM[0], nN_ = w ? nN[1] : nN[0];
        int wgid = (int)L; { const int q = nwg_ / NXCD, r = nwg_ % NXCD, xcd = wgid % NXCD, off = wgid / NXCD; wgid = (xcd < r ? xcd * (q + 1) : r * (q + 1) + (xcd - r) * q) + off; }
        const int nig = WGM * nN_, gid = wgid / nig, fm = gid * WGM, gsz = (nM_ - fm) < WGM ? (nM_ - fm) : WGM;
        u.pm = fm + ((wgid % nig) % gsz); u.pn = (wgid % nig) / gsz; u.which = w; return true;
    }
};
struct EpiB16 {
    static constexpr bool PERM = true;
    bf16_t* O0; bf16_t* O1; int ldc0, ldc1; float scale;
    __device__ __forceinline__ void operator()(const f32x4 (&acc)[2][2][4][2], const Unit& u, int wr, int wc, int fr, int fq) const {
        const int row0 = u.pm * BM + wr * 64 + fr, col0 = u.pn * BM + wc * 32 + 8 * fq;
        bf16_t* const O = u.which ? O1 : O0; const int ldc = u.which ? ldc1 : ldc0;
#pragma unroll
        for (int ai = 0; ai < 2; ++ai)
#pragma unroll
            for (int m = 0; m < 4; ++m) { bf16_t* rowp = O + (size_t)(row0 + ai * HALF + m * 16) * ldc + col0;
#pragma unroll
                for (int bj = 0; bj < 2; ++bj) { const f32x4 v0 = acc[ai][bj][m][0], v1 = acc[ai][bj][m][1];
                    u32x4 w; w.x = cvt_pk_bf16(v0[0], v0[1]); w.y = cvt_pk_bf16(v0[2], v0[3]); w.z = cvt_pk_bf16(v1[0], v1[1]); w.w = cvt_pk_bf16(v1[2], v1[3]);
                    *(u32x4*)(rowp + bj * HALF) = w; } }
    }
};
struct EpiBr {
    static constexpr bool PERM = true;
    bf16_t* T1; const bf16_t* gate0; const bf16_t* gate1; int ldg; bf16_t* O;
    __device__ __forceinline__ void operator()(const f32x4 (&acc)[2][2][4][2], const Unit& u, int wr, int wc, int fr, int fq) const {
        const int row0 = u.pm * BM + wr * 64 + fr, col0 = u.pn * BM + wc * 32 + 8 * fq;
        const bf16_t* const gate = u.which ? gate1 : gate0;
#pragma unroll
        for (int ai = 0; ai < 2; ++ai)
#pragma unroll
            for (int m = 0; m < 4; ++m) { const size_t r = (size_t)(row0 + ai * HALF + m * 16);
#pragma unroll
                for (int bj = 0; bj < 2; ++bj) { const f32x4 v0 = acc[ai][bj][m][0], v1 = acc[ai][bj][m][1];
                    const u32x4 gw = *(const u32x4*)(gate + r * ldg + col0 + bj * HALF);
                    bf16_t* tp = T1 + r * DM + col0 + bj * HALF;
                    f32x4 o0, o1;
                    o0[0] = sigmoidf_(bflo(gw.x)) * v0[0]; o0[1] = sigmoidf_(bfhi(gw.x)) * v0[1]; o0[2] = sigmoidf_(bflo(gw.y)) * v0[2]; o0[3] = sigmoidf_(bfhi(gw.y)) * v0[3];
                    o1[0] = sigmoidf_(bflo(gw.z)) * v1[0]; o1[1] = sigmoidf_(bfhi(gw.z)) * v1[1]; o1[2] = sigmoidf_(bflo(gw.w)) * v1[2]; o1[3] = sigmoidf_(bfhi(gw.w)) * v1[3];
                    if (u.which) { const u32x4 t = *(const u32x4*)tp;
                        o0[0] += bflo(t.x); o0[1] += bfhi(t.x); o0[2] += bflo(t.y); o0[3] += bfhi(t.y); o1[0] += bflo(t.z); o1[1] += bfhi(t.z); o1[2] += bflo(t.w); o1[3] += bfhi(t.w); }
                    if (u.which) {
                        int a = __builtin_amdgcn_cvt_pk_fp8_f32(clamp8(o0[0] * MQ_SCALE), clamp8(o0[1] * MQ_SCALE), 0, false); a = __builtin_amdgcn_cvt_pk_fp8_f32(clamp8(o0[2] * MQ_SCALE), clamp8(o0[3] * MQ_SCALE), a, true);
                        int b = __builtin_amdgcn_cvt_pk_fp8_f32(clamp8(o1[0] * MQ_SCALE), clamp8(o1[1] * MQ_SCALE), 0, false); b = __builtin_amdgcn_cvt_pk_fp8_f32(clamp8(o1[2] * MQ_SCALE), clamp8(o1[3] * MQ_SCALE), b, true);
                        u32x2 q8; q8.x = (unsigned)a; q8.y = (unsigned)b; *(u32x2*)((unsigned char*)O + r * DM + col0 + bj * HALF) = q8;
                    } else { u32x4 w; w.x = cvt_pk_bf16(o0[0], o0[1]); w.y = cvt_pk_bf16(o0[2], o0[3]); w.z = cvt_pk_bf16(o1[0], o1[1]); w.w = cvt_pk_bf16(o1[2], o1[3]); *(u32x4*)tp = w; } } }
    }
};
template <bool RB16> struct EpiResB {
    static constexpr bool PERM = true;
    bf16_t* C; const void* R; float alpha;
    __device__ __forceinline__ void operator()(const f32x4 (&acc)[2][2][4][2], const Unit& u, int wr, int wc, int fr, int fq) const {
        const int row0 = u.pm * BM + wr * 64 + fr, col0 = u.pn * BM + wc * 32 + 8 * fq;
#pragma unroll
        for (int ai = 0; ai < 2; ++ai)
#pragma unroll
            for (int m = 0; m < 4; ++m) { const size_t ro = (size_t)(row0 + ai * HALF + m * 16) * DM + col0;
#pragma unroll
                for (int bj = 0; bj < 2; ++bj) { f32x4 v0 = acc[ai][bj][m][0], v1 = acc[ai][bj][m][1];
                    if (RB16) { const u32x4 t = *(const u32x4*)((const bf16_t*)R + ro + bj * HALF);
                        v0[0] += alpha * bflo(t.x); v0[1] += alpha * bfhi(t.x); v0[2] += alpha * bflo(t.y); v0[3] += alpha * bfhi(t.y); v1[0] += alpha * bflo(t.z); v1[1] += alpha * bfhi(t.z); v1[2] += alpha * bflo(t.w); v1[3] += alpha * bfhi(t.w); }
                    else { const f32x4 r0 = *(const f32x4*)((const float*)R + ro + bj * HALF), r1 = *(const f32x4*)((const float*)R + ro + bj * HALF + 4); v0 = v0 + r0 * alpha; v1 = v1 + r1 * alpha; }
                    u32x4 w; w.x = cvt_pk_bf16(v0[0], v0[1]); w.y = cvt_pk_bf16(v0[2], v0[3]); w.z = cvt_pk_bf16(v1[0], v1[1]); w.w = cvt_pk_bf16(v1[2], v1[3]);
                    *(u32x4*)(C + ro + bj * HALF) = w; } }
    }
};
struct EpiRes {
    static constexpr bool PERM = false;
    float* C; const float* R; float alpha;
    __device__ __forceinline__ void operator()(const f32x4 (&acc)[2][2][4][2], const Unit& u, int wr, int wc, int fr, int fq) const {
        const int row0 = u.pm * BM + wr * 64 + fr, col0 = u.pn * BM + wc * 32 + 4 * fq;
#pragma unroll
        for (int ai = 0; ai < 2; ++ai)
#pragma unroll
            for (int m = 0; m < 4; ++m) { const size_t ro = (size_t)(row0 + ai * HALF + m * 16) * DM + col0;
#pragma unroll
                for (int bj = 0; bj < 2; ++bj)
#pragma unroll
                    for (int n = 0; n < 2; ++n) { f32x4 v = acc[ai][bj][m][n];
                        if (R) { const f32x4 rv = *(const f32x4*)(R + ro + bj * HALF + n * 16); v = v + rv * alpha; }
                        *(f32x4*)(C + ro + bj * HALF + n * 16) = v; } }
    }
};

typedef int i32x8 __attribute__((ext_vector_type(8)));
typedef int i32x4 __attribute__((ext_vector_type(4)));
template <class Epi, bool FP8 = false>
__device__ __forceinline__ void gemm_phase(LAS unsigned char* lds, const Gemm g, const StaticOrder& S, const Epi& E) {
    const int tid = threadIdx.x, wid = __builtin_amdgcn_readfirstlane(tid >> 6), lane = tid & 63, wr = wid >> 2, wc = wid & 3, fr = lane & 15, fq = lane >> 4;
    const int K = g.K, nt = K / BK;
    unsigned voffA[2], voffB[2];
#pragma unroll
    for (int i = 0; i < 2; ++i) { int R, C; stage_rc(tid * 16 + i * 8192, R, C); const int Rb = Epi::PERM ? ((R & ~31) + perm32(R & 31)) : R;
        voffA[i] = (unsigned)(R * g.lda + C) * 2u; voffB[i] = (unsigned)(Rb * g.ldb + C) * 2u; }
    const size_t kstep = (size_t)(BK * 2);
    const size_t hstepA = (size_t)HALF * g.lda * 2, hstepB = (size_t)HALF * g.ldb * 2;
    const size_t tstepA = 2 * hstepA, tstepB = 2 * hstepB;
    const unsigned ldsw = (unsigned)wid * 1024u;
    const int aoff = lds_byte(wr * 64 + fr, fq * 8), boff = lds_byte(wc * 32 + fr, fq * 8);
#define PG8_SA(b, h) (((b) * 2 + (h)) * HTB)
#define PG8_SB(b, h) ((4 + (b) * 2 + (h)) * HTB)
#define PG8_STAGE(bufoff, gbase, voff) do { _Pragma("unroll") for (int _i = 0; _i < 2; ++_i) \
        __builtin_amdgcn_global_load_lds((const unsigned*)((const char*)(gbase) + (voff)[_i]), (LAS unsigned*)(lds + (bufoff) + ldsw + _i * 8192), 16, 0, 0); } while (0)
#define PG8_RD4(off) (*(const LAS i32x4*)(lds + (off)))
#define PG8_LDA(dst, b, h) do { if (FP8) { _Pragma("unroll") for (int m = 0; m < 4; ++m) dst##8[m] = __builtin_shufflevector(PG8_RD4(PG8_SA(b, h) + aoff + m * 2048), PG8_RD4(PG8_SA(b, h) + aoff + m * 2048 + 1024), 0, 1, 2, 3, 4, 5, 6, 7); } \
        else { _Pragma("unroll") for (int m = 0; m < 4; ++m) _Pragma("unroll") for (int k = 0; k < 2; ++k) dst[m][k] = *(const LAS bf16x8*)(lds + PG8_SA(b, h) + aoff + m * 2048 + k * 1024); } } while (0)
#define PG8_LDB(dst, b, h) do { if (FP8) { _Pragma("unroll") for (int n = 0; n < 2; ++n) dst##8[n] = __builtin_shufflevector(PG8_RD4(PG8_SB(b, h) + boff + n * 2048), PG8_RD4(PG8_SB(b, h) + boff + n * 2048 + 1024), 0, 1, 2, 3, 4, 5, 6, 7); } \
        else { _Pragma("unroll") for (int n = 0; n < 2; ++n) _Pragma("unroll") for (int k = 0; k < 2; ++k) dst[n][k] = *(const LAS bf16x8*)(lds + PG8_SB(b, h) + boff + n * 2048 + k * 1024); } } while (0)
#define PG8_MMA(ai, bj, At, Bt) do { __builtin_amdgcn_s_setprio(1); \
        if (FP8) { _Pragma("unroll") for (int m = 0; m < 4; ++m) _Pragma("unroll") for (int n = 0; n < 2; ++n) \
            asm volatile("v_mfma_scale_f32_16x16x128_f8f6f4 %0, %1, %2, %0, %3, %4 op_sel_hi:[0,0,0]" : "+v"(acc[ai][bj][m][n]) : "v"(Bt##8[n]), "v"(At##8[m]), "v"(sc_b8), "v"(sc_a8)); } \
        else { _Pragma("unroll") for (int m = 0; m < 4; ++m) _Pragma("unroll") for (int n = 0; n < 2; ++n) _Pragma("unroll") for (int k = 0; k < 2; ++k) \
            acc[ai][bj][m][n] = __builtin_amdgcn_mfma_f32_16x16x32_bf16(Bt[n][k], At[m][k], acc[ai][bj][m][n], 0, 0, 0); } \
        __builtin_amdgcn_s_setprio(0); } while (0)
#define PG8_WAIT_V(n) asm volatile("s_waitcnt vmcnt(" #n ")" ::: "memory")
#define PG8_WAIT_L(n) asm volatile("s_waitcnt lgkmcnt(" #n ")" ::: "memory")
#define PG8_BAR __builtin_amdgcn_s_barrier()
#define PG8_SCHED __builtin_amdgcn_sched_barrier(0)
#define PG8_FSCHED do { if (FP8) __builtin_amdgcn_sched_barrier(0); } while (0)
    Unit cur, nxt; int ui = 0;
    if (!S.next(0, cur)) return;
    f32x4 acc[2][2][4][2];
#pragma unroll
    for (int a = 0; a < 2; ++a)
#pragma unroll
        for (int b = 0; b < 2; ++b)
#pragma unroll
            for (int m = 0; m < 4; ++m)
#pragma unroll
                for (int n = 0; n < 2; ++n) acc[a][b][m][n] = (f32x4){0.f, 0.f, 0.f, 0.f};
    bf16x8 At[4][2], B0[2][2], B1[2][2];
    i32x8 At8[4], B08[2], B18[2];
    const int sc_a8 = g.sca, sc_b8 = g.scb;
    const char* cA = (const char*)(cur.which ? g.A[1] : g.A[0]) + (size_t)cur.pm * tstepA; const char* cB = (const char*)(cur.which ? g.Bt[1] : g.Bt[0]) + (size_t)cur.pn * tstepB;
    PG8_STAGE(PG8_SB(0, 0), cB, voffB); PG8_STAGE(PG8_SA(0, 0), cA, voffA); PG8_STAGE(PG8_SB(0, 1), cB + hstepB, voffB); PG8_STAGE(PG8_SA(0, 1), cA + hstepA, voffA);
    if (wr == 1) PG8_BAR;
    PG8_WAIT_V(4); PG8_BAR;
    PG8_STAGE(PG8_SB(1, 0), cB + kstep, voffB); PG8_STAGE(PG8_SA(1, 0), cA + kstep, voffA); PG8_STAGE(PG8_SB(1, 1), cB + hstepB + kstep, voffB);
    PG8_WAIT_V(6); PG8_BAR;
    for (;;) {
        const bool has_next = S.next(ui + 1, nxt);
        const char* nA = has_next ? (const char*)(nxt.which ? g.A[1] : g.A[0]) + (size_t)nxt.pm * tstepA : cA; const char* nB = has_next ? (const char*)(nxt.which ? g.Bt[1] : g.Bt[0]) + (size_t)nxt.pn * tstepB : cB;
        for (int t = 0; t < nt; t += 2) {
            const bool last = (t == nt - 2);
            const char* a1 = cA + (size_t)(t + 1) * kstep;
            const char* a2 = last ? nA : cA + (size_t)(t + 2) * kstep; const char* b2 = last ? nB : cB + (size_t)(t + 2) * kstep;
            const char* a3 = a2 + kstep; const char* b3 = b2 + kstep;
            PG8_FSCHED; PG8_LDB(B0, 0, 0); PG8_SCHED; PG8_LDA(At, 0, 0); PG8_STAGE(PG8_SA(1, 1), a1 + hstepA, voffA);
            PG8_WAIT_L(8); PG8_BAR; PG8_WAIT_L(0); PG8_MMA(0, 0, At, B0); PG8_BAR; PG8_SCHED;
            PG8_FSCHED; PG8_LDB(B1, 0, 1); PG8_STAGE(PG8_SB(0, 0), b2, voffB);
            PG8_BAR; PG8_WAIT_L(0); PG8_MMA(0, 1, At, B1); PG8_BAR;
            PG8_FSCHED; PG8_LDA(At, 0, 1); PG8_STAGE(PG8_SA(0, 0), a2, voffA);
            PG8_BAR; PG8_WAIT_L(0); PG8_MMA(1, 0, At, B0); PG8_BAR; PG8_SCHED;
            PG8_STAGE(PG8_SB(0, 1), b2 + hstepB, voffB);
            PG8_WAIT_V(6); PG8_BAR; PG8_MMA(1, 1, At, B1); PG8_BAR; PG8_FSCHED;
            PG8_FSCHED; PG8_LDB(B0, 1, 0); PG8_SCHED; PG8_LDA(At, 1, 0); PG8_STAGE(PG8_SA(0, 1), a2 + hstepA, voffA);
            PG8_WAIT_L(8); PG8_BAR; PG8_WAIT_L(0); PG8_MMA(0, 0, At, B0); PG8_BAR; PG8_SCHED;
            PG8_FSCHED; PG8_LDB(B1, 1, 1); PG8_STAGE(PG8_SB(1, 0), b3, voffB);
            PG8_BAR; PG8_WAIT_L(0); PG8_MMA(0, 1, At, B1); PG8_BAR;
            PG8_FSCHED; PG8_LDA(At, 1, 1); PG8_STAGE(PG8_SA(1, 0), a3, voffA);
            PG8_BAR; PG8_WAIT_L(0); PG8_MMA(1, 0, At, B0); PG8_BAR; PG8_SCHED;
            PG8_STAGE(PG8_SB(1, 1), b3 + hstepB, voffB);
            PG8_WAIT_V(6); PG8_BAR; PG8_MMA(1, 1, At, B1); PG8_BAR; PG8_FSCHED;
        }
        if (FP8) asm volatile("s_nop 15\n\ts_nop 15" ::: "memory");
        E(acc, cur, wr, wc, fr, fq);
        if (!has_next) break;
#pragma unroll
        for (int a = 0; a < 2; ++a)
#pragma unroll
            for (int b = 0; b < 2; ++b)
#pragma unroll
                for (int m = 0; m < 4; ++m)
#pragma unroll
                    for (int n = 0; n < 2; ++n) acc[a][b][m][n] = (f32x4){0.f, 0.f, 0.f, 0.f};
        cur = nxt; cA = nA; cB = nB; ++ui;
    }
    PG8_WAIT_V(0);
    if (wr == 0) PG8_BAR;
    PG8_BAR;
#undef PG8_SA
#undef PG8_SB
#undef PG8_STAGE
#undef PG8_LDA
#undef PG8_LDB
#undef PG8_MMA
#undef PG8_RD4
#undef PG8_WAIT_V
#undef PG8_WAIT_L
#undef PG8_BAR
#undef PG8_SCHED
#undef PG8_FSCHED
}
template <class Epi, bool FP8 = false>
__device__ __forceinline__ void run_gemm2(unsigned char* lds, const bf16_t* A0, const bf16_t* B0, int M0, int N0, const bf16_t* A1, const bf16_t* B1, int M1, int N1, const Epi& E, int K2 = DM, int eneg = 15) {
    Gemm g; g.A[0] = A0; g.Bt[0] = B0; g.M[0] = M0; g.N[0] = N0; g.A[1] = A1; g.Bt[1] = B1; g.M[1] = M1; g.N[1] = N1; g.K = K2; g.lda = K2; g.ldb = K2;
    { const int ea = 127 - eneg / 2, eb = 127 - (eneg - eneg / 2); g.sca = ea * 0x01010101; g.scb = eb * 0x01010101; }
    StaticOrder S; S.init(g, gridDim.x, blockIdx.x);
    gemm_phase<Epi, FP8>((LAS unsigned char*)lds, g, S, E);
    __syncthreads();
}
}

__device__ void ph_prep_x(const Params& p, unsigned char* lds_) {
    float* rowbuf = (float*)lds_;
    bf16_t* Xb = (bf16_t*)(p.ws + OFF_XB); float* GA = (float*)(p.ws + OFF_GATES);
    const int tid = threadIdx.x, wid = tid >> 6, lane = tid & 63;
    float wr[3][32]; float bias[3]; int colv[3];
#pragma unroll
    for (int c = 0; c < 3; ++c) {
        const int gc = 3 * wid + c; colv[c] = gc < 8 ? 6144 + gc : 12296 + (gc - 8);
        bias[c] = gc < 8 ? p.gate_b[gc] : p.fox_f_b[gc - 8];
    }
    {
        const float* rp = p.w_in + (size_t)(4 * lane) * W_IN_LD;
#pragma unroll
        for (int j = 0; j < 8; ++j) {
#pragma unroll
            for (int i = 0; i < 4; ++i) {
                asm volatile("" : "+v"(rp));
                wr[0][j * 4 + i] = rp[colv[0]]; wr[1][j * 4 + i] = rp[colv[1]]; wr[2][j * 4 + i] = rp[colv[2]];
                rp += (i == 3) ? (size_t)253 * W_IN_LD : (size_t)W_IN_LD;
            }
        }
    }
    int it = 0;
    for (int tg = blockIdx.x; tg < T_TOK / 4; tg += gridDim.x, ++it) {
        float* buf = rowbuf + (it & 1) * 8192;
        float4 v[4];
#pragma unroll
        for (int c = 0; c < 4; ++c) v[c] = *(const float4*)(p.x + (size_t)(4 * tg + c) * DM + 4 * tid);
#pragma unroll
        for (int c = 0; c < 4; ++c) { int w8 = __builtin_amdgcn_cvt_pk_fp8_f32(clamp8(v[c].x * XQ_SCALE), clamp8(v[c].y * XQ_SCALE), 0, false); w8 = __builtin_amdgcn_cvt_pk_fp8_f32(clamp8(v[c].z * XQ_SCALE), clamp8(v[c].w * XQ_SCALE), w8, true);
            *(int*)((unsigned char*)Xb + (size_t)(4 * tg + c) * DM + 4 * tid) = w8; *(float4*)(buf + c * 2048 + 4 * tid) = v[c]; }
        __syncthreads();
#pragma unroll
        for (int c = 0; c < 4; ++c) {
            float a0 = 0.f, a1 = 0.f, a2 = 0.f;
#pragma unroll
            for (int j = 0; j < 8; ++j) {
                const float4 xv = *(const float4*)(buf + c * 2048 + 4 * lane + 256 * j);
                a0 += xv.x * wr[0][4 * j] + xv.y * wr[0][4 * j + 1] + xv.z * wr[0][4 * j + 2] + xv.w * wr[0][4 * j + 3];
                a1 += xv.x * wr[1][4 * j] + xv.y * wr[1][4 * j + 1] + xv.z * wr[1][4 * j + 2] + xv.w * wr[1][4 * j + 3];
                a2 += xv.x * wr[2][4 * j] + xv.y * wr[2][4 * j + 1] + xv.z * wr[2][4 * j + 2] + xv.w * wr[2][4 * j + 3];
            }
            a0 = wsum(a0); a1 = wsum(a1); a2 = wsum(a2);
            if (lane == 0) { float* gp = GA + (size_t)(4 * tg + c) * 24 + 3 * wid; gp[0] = a0 + bias[0]; gp[1] = a1 + bias[1]; gp[2] = a2 + bias[2]; }
        }
    }
    __syncthreads();
}

__device__ void ph_prep_w(const Params& p, unsigned char* lds_) {
    bf16_t* tT = (bf16_t*)lds_;
    const int tid = threadIdx.x;
#define PW_DECODE(gt_) do { const int gt = (gt_); isf8 = gt < 2048; \
        if (gt < 2048) { src = p.w_in; ld = W_IN_LD; \
            if (gt < 256) { col0 = 0; dbase = p.ws + OFF_WMAIN; drow = 0; lt = gt; } \
            else if (gt < 512) { col0 = 2048; dbase = p.ws + OFF_WV; drow = 0; lt = gt - 256; } \
            else if (gt < 768) { col0 = 4096; dbase = p.ws + OFF_WMAIN; drow = 2048; lt = gt - 512; } \
            else if (gt < 1280) { col0 = 6152; dbase = p.ws + OFF_WMAIN; drow = 4096; lt = gt - 768; } \
            else if (gt < 1536) { col0 = 10248; dbase = p.ws + OFF_WV; drow = 2048; lt = gt - 1280; } \
            else { col0 = 12312; dbase = p.ws + OFF_WMAIN; drow = 8192; lt = gt - 1536; } \
        } else if (gt < 3584) { const int j = (gt - 2048) >> 8; lt = (gt - 2048) & 255; ld = DM; col0 = 0; drow = 0; isf8 = (j != 5); \
            src = j == 0 ? p.w_sq[0] : j == 1 ? p.w_sq[1] : j == 2 ? p.w_sq[2] : j == 3 ? p.w_sq[3] : j == 4 ? p.w_sq[4] : p.w_sq[5]; \
            dbase = p.ws + OFF_WSQ + (size_t)j * 8 * MiB; \
        } else { src = p.w_xkv; ld = 4096; col0 = 0; drow = 0; lt = gt - 3584; dbase = p.ws + OFF_WXKV; isf8 = true; } } while (0)
#define PW_LOAD() do { if (isf8) { const int k0 = (lt & 15) * 128, n0 = (lt >> 4) * 128; _Pragma("unroll") for (int i = 0; i < 8; ++i) { const int q = tid + 512 * i, krow = q >> 5, c4 = q & 31; \
            v[i] = *(const float4*)(src + (size_t)(k0 + krow) * ld + col0 + n0 + 4 * c4); } } \
        else { const int k0 = (lt & 31) * 64, n0 = (lt >> 5) * 256; _Pragma("unroll") for (int i = 0; i < 8; ++i) { const int q = tid + 512 * i, krow = q >> 6, c4 = q & 63; \
            v[i] = *(const float4*)(src + (size_t)(k0 + krow) * ld + col0 + n0 + 4 * c4); } } } while (0)
    const float* src; unsigned char* dbase; int ld, col0, lt, drow; bool isf8;
    unsigned char* tT8 = lds_;
    float4 v[8];
    if ((int)blockIdx.x < 4096) { PW_DECODE(blockIdx.x); PW_LOAD(); }
    for (int gt0 = blockIdx.x; gt0 < 4096; gt0 += gridDim.x) {
        unsigned char* const dcur = dbase; const bool f8 = isf8; const int k0 = f8 ? (lt & 15) * 128 : (lt & 31) * 64, n0 = f8 ? (lt >> 4) * 128 : (lt >> 5) * 256, drc = drow;
        if (f8) {
#pragma unroll
            for (int i = 0; i < 8; ++i) { const int q = tid + 512 * i, krow = q >> 5, c4 = q & 31;
                const int a = __builtin_amdgcn_cvt_pk_fp8_f32(clamp8(v[i].x * WQ_SCALE), clamp8(v[i].y * WQ_SCALE), 0, false), b = __builtin_amdgcn_cvt_pk_fp8_f32(clamp8(v[i].z * WQ_SCALE), clamp8(v[i].w * WQ_SCALE), 0, false);
                tT8[(4 * c4 + 0) * 132 + krow] = (unsigned char)(a & 0xff); tT8[(4 * c4 + 1) * 132 + krow] = (unsigned char)((a >> 8) & 0xff);
                tT8[(4 * c4 + 2) * 132 + krow] = (unsigned char)(b & 0xff); tT8[(4 * c4 + 3) * 132 + krow] = (unsigned char)((b >> 8) & 0xff); }
        } else {
#pragma unroll
            for (int i = 0; i < 8; ++i) { const int q = tid + 512 * i, krow = q >> 6, c4 = q & 63;
                const unsigned a = cvt_pk_bf16(v[i].x, v[i].y), b = cvt_pk_bf16(v[i].z, v[i].w);
                tT[(4 * c4 + 0) * 66 + krow] = (bf16_t)(a & 0xffffu); tT[(4 * c4 + 1) * 66 + krow] = (bf16_t)(a >> 16);
                tT[(4 * c4 + 2) * 66 + krow] = (bf16_t)(b & 0xffffu); tT[(4 * c4 + 3) * 66 + krow] = (bf16_t)(b >> 16); }
        }
        __syncthreads();
        if (gt0 + (int)gridDim.x < 4096) { PW_DECODE(gt0 + (int)gridDim.x); PW_LOAD(); }
        if (f8) {
#pragma unroll
            for (int i = 0; i < 2; ++i) { const int q = tid + 512 * i, n = q >> 3, kg = q & 7; const unsigned* rp = (const unsigned*)(tT8 + n * 132 + kg * 16);
                u32x4 w; w.x = rp[0]; w.y = rp[1]; w.z = rp[2]; w.w = rp[3];
                *(u32x4*)(dcur + (size_t)(drc + n0 + n) * DM + k0 + kg * 16) = w; }
        } else {
#pragma unroll
            for (int i = 0; i < 4; ++i) { const int q = tid + 512 * i, n = q >> 3, kg = q & 7; const unsigned* rp = (const unsigned*)(tT + n * 66 + kg * 8);
                u32x4 w; w.x = rp[0]; w.y = rp[1]; w.z = rp[2]; w.w = rp[3];
                *(u32x4*)((bf16_t*)dcur + (size_t)(drc + n0 + n) * DM + k0 + kg * 8) = w; }
        }
        __syncthreads();
    }
#undef PW_DECODE
#undef PW_LOAD
}

__device__ void cvt_f32_bf16(const float* src, bf16_t* dst, size_t n8) {
    for (size_t i = (size_t)blockIdx.x * blockDim.x + threadIdx.x; i < n8; i += (size_t)gridDim.x * blockDim.x) {
        const float4 a = *(const float4*)(src + i * 8), b = *(const float4*)(src + i * 8 + 4);
        u32x4 w; w.x = cvt_pk_bf16(a.x, a.y); w.y = cvt_pk_bf16(a.z, a.w); w.z = cvt_pk_bf16(b.x, b.y); w.w = cvt_pk_bf16(b.z, b.w);
        *(u32x4*)(dst + i * 8) = w; }
}

typedef float f32x2 __attribute__((ext_vector_type(2)));
__device__ void cvt_f32_fp8(const float* src, unsigned char* dst, size_t n16, float scale) {
    for (size_t i = (size_t)blockIdx.x * blockDim.x + threadIdx.x; i < n16; i += (size_t)gridDim.x * blockDim.x) {
        u32x4 w;
#pragma unroll
        for (int k = 0; k < 4; ++k) { const float4 a = *(const float4*)(src + i * 16 + 4 * k);
            const float x0 = fminf(fmaxf(a.x * scale, -440.f), 440.f), x1 = fminf(fmaxf(a.y * scale, -440.f), 440.f), x2 = fminf(fmaxf(a.z * scale, -440.f), 440.f), x3 = fminf(fmaxf(a.w * scale, -440.f), 440.f);
            int v = __builtin_amdgcn_cvt_pk_fp8_f32(x0, x1, 0, false); v = __builtin_amdgcn_cvt_pk_fp8_f32(x2, x3, v, true); w[k] = (unsigned)v; }
        *(u32x4*)(dst + i * 16) = w; }
}

__device__ void ph_scans(const Params& p) {
    const int wid = threadIdx.x >> 6, lane = threadIdx.x & 63;
    if (wid != 0) return;
    const float* GA = (const float*)(p.ws + OFF_GATES);
    for (int q = blockIdx.x; q < 80; q += gridDim.x) {
        if (q < 64) {
            const int b = q >> 4, h = q & 15; float v[32]; float run = 0.f;
#pragma unroll
            for (int i = 0; i < 32; ++i) { const float z = GA[(size_t)(b * SEQ + 32 * lane + i) * 24 + 8 + h]; run += logsigf_(z); v[i] = run; }
            float inc = run;
#pragma unroll
            for (int o = 1; o < 64; o <<= 1) { const float t = __shfl_up(inc, o); if (lane >= o) inc += t; }
            const float excl = inc - run; float* F = (float*)(p.ws + OFF_FOXF) + (size_t)(b * 16 + h) * SEQ + 32 * lane;
#pragma unroll
            for (int i = 0; i < 32; ++i) F[i] = (v[i] + excl) * 1.4426950408889634f;
        } else {
            const int b = (q - 64) >> 2, h = (q - 64) & 3; float v[32]; float run = 0.f;
#pragma unroll
            for (int i = 0; i < 32; ++i) { const float z = GA[(size_t)(b * SEQ + 32 * lane + i) * 24 + 4 + h]; run += logsigf_(z); v[i] = run; }
            float inc = run;
#pragma unroll
            for (int o = 1; o < 64; o <<= 1) { const float t = __shfl_up(inc, o); if (lane >= o) inc += t; }
            const float excl = inc - run;
            float* FC = (float*)(p.ws + OFF_MLFC) + (size_t)(b * 4 + h) * SEQ + 32 * lane;
            float* BI = (float*)(p.ws + OFF_MLB) + (size_t)(b * 4 + h) * SEQ + 32 * lane;
            float* MP = (float*)(p.ws + OFF_MLMP) + (size_t)(b * 4 + h) * SEQ + 32 * lane;
            float rmax = -INFINITY;
#pragma unroll
            for (int i = 0; i < 32; ++i) { const float fc = v[i] + excl; FC[i] = fc * 1.4426950408889634f; const float ip = GA[(size_t)(b * SEQ + 32 * lane + i) * 24 + h];
                const float bi = ip - fc; BI[i] = bi * 1.4426950408889634f; rmax = fmaxf(rmax, bi); v[i] = rmax; }
            float incm = rmax;
#pragma unroll
            for (int o = 1; o < 64; o <<= 1) { const float t = __shfl_up(incm, o); if (lane >= o) incm = fmaxf(incm, t); }
            float exm = __shfl_up(incm, 1); if (lane == 0) exm = -INFINITY;
#pragma unroll
            for (int i = 0; i < 32; ++i) MP[i] = fmaxf(v[i], exm) * 1.4426950408889634f;
        }
    }
}

__device__ void ph_conv(const Params& p) {
    const bf16_t* P1 = (const bf16_t*)(p.ws + OFF_P1); bf16_t* QKc = (bf16_t*)(p.ws + OFF_QKC);
    const int nthr = gridDim.x * blockDim.x;
    for (int i0 = blockIdx.x * blockDim.x + threadIdx.x; i0 < T_TOK * 256; i0 += 4 * nthr) {
        u32x4 r[4][4]; bool ok[4];
#pragma unroll
        for (int u = 0; u < 4; ++u) { const int i = i0 + u * nthr; ok[u] = i < T_TOK * 256; const int tok = i >> 8, c8 = (i & 255) * 8, s = tok & (SEQ - 1);
#pragma unroll
            for (int j = 0; j < 4; ++j) r[u][j] = (ok[u] && s - 3 + j >= 0) ? *(const u32x4*)(P1 + (size_t)(tok - 3 + j) * P1_LD + c8) : (u32x4){0u, 0u, 0u, 0u}; }
#pragma unroll
        for (int u = 0; u < 4; ++u) { if (!ok[u]) continue;
            const int i = i0 + u * nthr; const int tok = i >> 8, c8 = (i & 255) * 8;
            float acc[8];
            { const float4 b0 = *(const float4*)(p.conv_b + c8), b1 = *(const float4*)(p.conv_b + c8 + 4);
              acc[0] = b0.x; acc[1] = b0.y; acc[2] = b0.z; acc[3] = b0.w; acc[4] = b1.x; acc[5] = b1.y; acc[6] = b1.z; acc[7] = b1.w; }
#pragma unroll
            for (int j = 0; j < 4; ++j) {
                const float4 w0 = *(const float4*)(p.conv_w + j * 2048 + c8), w1 = *(const float4*)(p.conv_w + j * 2048 + c8 + 4);
                acc[0] += w0.x * bflo(r[u][j].x); acc[1] += w0.y * bfhi(r[u][j].x); acc[2] += w0.z * bflo(r[u][j].y); acc[3] += w0.w * bfhi(r[u][j].y);
                acc[4] += w1.x * bflo(r[u][j].z); acc[5] += w1.y * bfhi(r[u][j].z); acc[6] += w1.z * bflo(r[u][j].w); acc[7] += w1.w * bfhi(r[u][j].w);
            }
            const float sc = c8 >= 1024 ? 0.0625f : 1.0f;
#pragma unroll
            for (int e = 0; e < 8; ++e) acc[e] = acc[e] * sigmoidf_(acc[e]) * sc;
            u32x4 w; w.x = cvt_pk_bf16(acc[0], acc[1]); w.y = cvt_pk_bf16(acc[2], acc[3]); w.z = cvt_pk_bf16(acc[4], acc[5]); w.w = cvt_pk_bf16(acc[6], acc[7]);
            *(u32x4*)(QKc + (size_t)tok * DM + c8) = w; }
    }
}

template <int DQ, int DVT, int MODE, int QW>
__device__ __forceinline__ void attn_item(const Params& p, unsigned char* lds_, int b, int h, int qblk, int dvh) {
    constexpr int KLD = DQ + 8, VLD = 72, TILE_E = 64 * KLD + DVT * VLD, BQ = 128 * QW;
    bf16_t* Ks = (bf16_t*)lds_;
    bf16_t* Vs = Ks + 64 * KLD;
    const int tid = threadIdx.x, wid = tid >> 6, lane = tid & 63, n = lane & 15, g = lane >> 4;
    const int q0 = qblk * BQ, wq0 = q0 + 16 * QW * wid;
    const bf16_t* Qp; const bf16_t* Kbase; const bf16_t* VTb; const float* kbias; int ldk, ldq;
    if (MODE == 0) { const bf16_t* P1 = (const bf16_t*)(p.ws + OFF_P1);
        Qp = P1 + ((size_t)b * SEQ + wq0 + n) * P1_LD + 4096 + h * 128; ldq = P1_LD; Kbase = P1 + (size_t)b * SEQ * P1_LD + 6144 + h * 128; ldk = P1_LD;
        VTb = (const bf16_t*)(p.ws + OFF_VT) + (size_t)(2048 + h * 128) * T_TOK + (size_t)b * SEQ;
        kbias = (const float*)(p.ws + OFF_FOXF) + (size_t)(b * 16 + h) * SEQ;
    } else { const bf16_t* QKc = (const bf16_t*)(p.ws + OFF_QKC);
        Qp = QKc + ((size_t)b * SEQ + wq0 + n) * DM + h * 256; ldq = DM; Kbase = QKc + (size_t)b * SEQ * DM + 1024 + h * 256; ldk = DM;
        VTb = (const bf16_t*)(p.ws + OFF_VT) + (size_t)(h * 512 + dvh * 256) * T_TOK + (size_t)b * SEQ;
        kbias = (const float*)(p.ws + OFF_MLB) + (size_t)(b * 4 + h) * SEQ;
    }
    bf16x8 qf[QW][DQ / 32];
#pragma unroll
    for (int qi = 0; qi < QW; ++qi)
#pragma unroll
        for (int ks = 0; ks < DQ / 32; ++ks) qf[qi][ks] = *(const bf16x8*)(Qp + (size_t)(16 * qi) * ldq + ks * 32 + g * 8);
    f32x4 O[QW][DVT / 16];
    float m_run[QW], l_part[QW], mp_t[QW];
#pragma unroll
    for (int qi = 0; qi < QW; ++qi) { m_run[qi] = -INFINITY; l_part[qi] = 0.f;
        mp_t[qi] = (MODE == 1) ? ((const float*)(p.ws + OFF_MLMP))[(size_t)(b * 4 + h) * SEQ + wq0 + 16 * qi + n] : 0.f;
#pragma unroll
        for (int i = 0; i < DVT / 16; ++i) O[qi][i] = (f32x4){0.f, 0.f, 0.f, 0.f}; }
    const float F0 = (MODE == 0) ? kbias[q0] : 0.f;
    const float scale = 0.08838834764831845f * 1.4426950408889634f;
    const int nkb = (q0 + BQ) / 64;
    u32x4 kreg[DQ / 64], vreg[DVT / 64];
#define ATT_LOAD(k0_) do { _Pragma("unroll") for (int i = 0; i < DQ / 64; ++i) { const int q = tid + 512 * i, row = q / (DQ / 8), cc = q % (DQ / 8); \
            kreg[i] = *(const u32x4*)(Kbase + (size_t)((k0_) + row) * ldk + cc * 8); } \
        _Pragma("unroll") for (int i = 0; i < DVT / 64; ++i) { const int q = tid + 512 * i, d = q >> 3, cc = q & 7; \
            vreg[i] = *(const u32x4*)(VTb + (size_t)d * T_TOK + (k0_) + cc * 8); } } while (0)
#define ATT_STORE(buf_) do { bf16_t* Kd = Ks + (buf_) * TILE_E; bf16_t* Vd = Vs + (buf_) * TILE_E; \
        _Pragma("unroll") for (int i = 0; i < DQ / 64; ++i) { const int q = tid + 512 * i, row = q / (DQ / 8), cc = q % (DQ / 8); *(u32x4*)(Kd + row * KLD + cc * 8) = kreg[i]; } \
        _Pragma("unroll") for (int i = 0; i < DVT / 64; ++i) { const int q = tid + 512 * i, d = q >> 3, cc = q & 7; *(u32x4*)(Vd + d * VLD + cc * 8) = vreg[i]; } } while (0)
    int kb_lo = 0, kb_w = 0;
    { const int l1 = lane + 1; const float* mono = (MODE == 0) ? kbias : (const float*)(p.ws + OFF_MLMP) + (size_t)(b * 4 + h) * SEQ;
      const float sg = (MODE == 0) ? 1.0f : -1.0f;
      const float ref0 = mono[q0], refw = mono[wq0];
      const float vi = (64 * l1 <= wq0) ? mono[64 * l1 - 1] : 0.f;
      const bool c0 = (64 * l1 <= q0) && (sg * (ref0 - vi) < -69.25f), cw = (64 * l1 <= wq0) && (sg * (refw - vi) < -69.25f);
      kb_lo = (int)__builtin_popcountll(__builtin_amdgcn_ballot_w64(c0)); kb_w = (int)__builtin_popcountll(__builtin_amdgcn_ballot_w64(cw)); }
    ATT_LOAD(64 * kb_lo);
    __syncthreads();
    ATT_STORE(0);
    if (kb_lo + 1 < nkb) ATT_LOAD(64 * kb_lo + 64);
    __syncthreads();
    for (int kb = kb_lo; kb < nkb; ++kb) {
        const int k0 = kb * 64, cur = (kb - kb_lo) & 1;
        if (kb + 1 < nkb) { ATT_STORE(cur ^ 1); if (kb + 2 < nkb) ATT_LOAD(k0 + 128); }
        const bf16_t* Kc = Ks + cur * TILE_E; const bf16_t* Vc = Vs + cur * TILE_E;
        if (k0 <= wq0 + 16 * QW - 1 && kb >= kb_w) {
            f32x4 S[QW][4];
#pragma unroll
            for (int kt = 0; kt < 4; ++kt) {
#pragma unroll
                for (int qi = 0; qi < QW; ++qi) S[qi][kt] = (f32x4){0.f, 0.f, 0.f, 0.f};
#pragma unroll
                for (int ks = 0; ks < DQ / 32; ++ks) { const bf16x8 a = *(const bf16x8*)(Kc + (16 * kt + n) * KLD + ks * 32 + g * 8);
#pragma unroll
                    for (int qi = 0; qi < QW; ++qi) S[qi][kt] = __builtin_amdgcn_mfma_f32_16x16x32_bf16(a, qf[qi][ks], S[qi][kt], 0, 0, 0); } }
            const bool need_mask = (k0 + 63 > wq0);
            bf16x8 pf[QW][2];
#pragma unroll
            for (int qi = 0; qi < QW; ++qi) {
                const int t = wq0 + 16 * qi + n;
                float pv[4][4];
                if (MODE == 0) {
                    float mx = -INFINITY;
#pragma unroll
                    for (int kt = 0; kt < 4; ++kt) { const float4 fb = *(const float4*)(kbias + k0 + 16 * kt + 4 * g); const float fbv[4] = {fb.x, fb.y, fb.z, fb.w};
#pragma unroll
                        for (int j = 0; j < 4; ++j) { const int s = k0 + 16 * kt + 4 * g + j; float z = S[qi][kt][j] * scale + (F0 - fbv[j]); if (need_mask) z = (s > t) ? -INFINITY : z; pv[kt][j] = z; mx = fmaxf(mx, z); } }
                    mx = fmaxf(mx, __shfl_xor(mx, 16)); mx = fmaxf(mx, __shfl_xor(mx, 32));
                    const float m_new = fmaxf(m_run[qi], mx); const float alpha = __builtin_amdgcn_exp2f(m_run[qi] - m_new); m_run[qi] = m_new;
                    float sum = 0.f;
#pragma unroll
                    for (int kt = 0; kt < 4; ++kt)
#pragma unroll
                        for (int j = 0; j < 4; ++j) { const float e = __builtin_amdgcn_exp2f(pv[kt][j] - m_new); pv[kt][j] = e; sum += e; }
                    l_part[qi] = l_part[qi] * alpha + sum;
#pragma unroll
                    for (int i = 0; i < DVT / 16; ++i) O[qi][i] = O[qi][i] * alpha;
                } else {
#pragma unroll
                    for (int kt = 0; kt < 4; ++kt) { const float4 fb = *(const float4*)(kbias + k0 + 16 * kt + 4 * g); const float fbv[4] = {fb.x, fb.y, fb.z, fb.w};
#pragma unroll
                        for (int j = 0; j < 4; ++j) { const int s = k0 + 16 * kt + 4 * g + j; const float e = __builtin_amdgcn_exp2f(fbv[j] - mp_t[qi]) * S[qi][kt][j]; const float pe = (!need_mask || s <= t) ? e : 0.f; pv[kt][j] = pe; l_part[qi] += pe; } }
                }
#pragma unroll
                for (int kk = 0; kk < 2; ++kk) { u32x4 w; w.x = cvt_pk_bf16(pv[2 * kk][0], pv[2 * kk][1]); w.y = cvt_pk_bf16(pv[2 * kk][2], pv[2 * kk][3]);
                    w.z = cvt_pk_bf16(pv[2 * kk + 1][0], pv[2 * kk + 1][1]); w.w = cvt_pk_bf16(pv[2 * kk + 1][2], pv[2 * kk + 1][3]); pf[qi][kk] = __builtin_bit_cast(bf16x8, w); }
            }
#pragma unroll
            for (int dt = 0; dt < DVT / 16; ++dt)
#pragma unroll
                for (int kk = 0; kk < 2; ++kk) { const bf16_t* vp = Vc + (16 * dt + n) * VLD + 32 * kk + 4 * g;
                    const u32x2 lo = *(const u32x2*)vp, hi = *(const u32x2*)(vp + 16); u32x4 w; w.x = lo.x; w.y = lo.y; w.z = hi.x; w.w = hi.y;
#pragma unroll
                    for (int qi = 0; qi < QW; ++qi) O[qi][dt] = __builtin_amdgcn_mfma_f32_16x16x32_bf16(__builtin_bit_cast(bf16x8, w), pf[qi][kk], O[qi][dt], 0, 0, 0); }
        }
        __syncthreads();
    }
#undef ATT_LOAD
#undef ATT_STORE
#pragma unroll
    for (int qi = 0; qi < QW; ++qi) {
        const int t = wq0 + 16 * qi + n; const size_t tokq = (size_t)b * SEQ + t;
        float l = l_part[qi]; l += __shfl_xor(l, 16); l += __shfl_xor(l, 32);
        if (MODE == 0) {
            unsigned char* op8 = p.ws + OFF_YB + tokq * DM + h * 128 + 4 * g; const float sv = (1.0f / l) * XQ_SCALE;
#pragma unroll
            for (int dt = 0; dt < DVT / 16; ++dt) { int a = __builtin_amdgcn_cvt_pk_fp8_f32(clamp8(O[qi][dt][0] * sv), clamp8(O[qi][dt][1] * sv), 0, false); a = __builtin_amdgcn_cvt_pk_fp8_f32(clamp8(O[qi][dt][2] * sv), clamp8(O[qi][dt][3] * sv), a, true); *(int*)(op8 + 16 * dt) = a; }
        } else {
            const float mt = ((const float*)(p.ws + OFF_MLFC))[(size_t)(b * 4 + h) * SEQ + t] + mp_t[qi]; const float inv = 1.0f / fmaxf(fabsf(l), __builtin_amdgcn_exp2f(-mt));
            bf16_t* op = (bf16_t*)(p.ws + OFF_HPRE) + tokq * DM + h * 512 + dvh * 256 + 4 * g;
#pragma unroll
            for (int dt = 0; dt < DVT / 16; ++dt) { u32x2 w; w.x = cvt_pk_bf16(O[qi][dt][0] * inv, O[qi][dt][1] * inv); w.y = cvt_pk_bf16(O[qi][dt][2] * inv, O[qi][dt][3] * inv); *(u32x2*)(op + 16 * dt) = w; }
        }
    }
}

__device__ void ph_mixers(const Params& p, unsigned char* lds_, int rep) {
    int* sitem = (int*)(lds_ + LDS_BYTES - 16);
    unsigned* ctr = (unsigned*)(p.ws + OFF_CTL) + 64 * rep;
    for (;;) {
        __syncthreads();
        if (threadIdx.x == 0) *sitem = (int)atomicAdd(ctr, 1u);
        __syncthreads();
        const int I = *sitem;
        if (I >= 512) break;
        attn_item<128, 128, 0, 2>(p, lds_, I & 3, 15 - ((I & 63) >> 2), 7 - (I >> 6), 0);
    }
    for (;;) {
        __syncthreads();
        if (threadIdx.x == 0) *sitem = (int)atomicAdd(ctr + 16, 1u);
        __syncthreads();
        const int I = *sitem;
        if (I >= 512) break;
        const int ww = I & 31;
        attn_item<256, 256, 1, 1>(p, lds_, ww >> 3, (ww >> 1) & 3, 15 - (I >> 5), ww & 1);
    }
}

__device__ void ph_mlnorm(const Params& p, int blk, int nblk) {
    const int wid = threadIdx.x >> 6, lane = threadIdx.x & 63;
    const bf16_t* HP = (const bf16_t*)(p.ws + OFF_HPRE); const bf16_t* P1 = (const bf16_t*)(p.ws + OFF_P1); unsigned char* HB = p.ws + OFF_HB;
    const int nw = nblk * 8;
    for (int item0 = blk * 8 + wid; item0 < T_TOK * 4; item0 += 2 * nw) {
        u32x4 r[2], og[2]; bool ok[2];
#pragma unroll
        for (int u = 0; u < 2; ++u) { const int item = item0 + u * nw; ok[u] = item < T_TOK * 4; const int tok = item >> 2, h = item & 3;
            if (ok[u]) { r[u] = *(const u32x4*)(HP + (size_t)tok * DM + h * 512 + 8 * lane); og[u] = *(const u32x4*)(P1 + (size_t)tok * P1_LD + 2048 + h * 512 + 8 * lane); } }
#pragma unroll
        for (int u = 0; u < 2; ++u) { if (!ok[u]) continue;
            const int item = item0 + u * nw; const int tok = item >> 2, h = item & 3;
            float v[8] = {bflo(r[u].x), bfhi(r[u].x), bflo(r[u].y), bfhi(r[u].y), bflo(r[u].z), bfhi(r[u].z), bflo(r[u].w), bfhi(r[u].w)};
            float s = 0.f;
#pragma unroll
            for (int e = 0; e < 8; ++e) s += v[e];
            const float mean = wsum(s) * (1.0f / 512.0f);
            float q = 0.f;
#pragma unroll
            for (int e = 0; e < 8; ++e) { v[e] -= mean; q += v[e] * v[e]; }
            const float rstd = rsqrtf(wsum(q) * (1.0f / 512.0f) + LN_EPS);
            const float o[8] = {bflo(og[u].x), bfhi(og[u].x), bflo(og[u].y), bfhi(og[u].y), bflo(og[u].z), bfhi(og[u].z), bflo(og[u].w), bfhi(og[u].w)};
            const float4 n0 = *(const float4*)(p.norm_w + h * 512 + 8 * lane), n1 = *(const float4*)(p.norm_w + h * 512 + 8 * lane + 4);
            const float nwv[8] = {n0.x, n0.y, n0.z, n0.w, n1.x, n1.y, n1.z, n1.w};
            float y[8];
#pragma unroll
            for (int e = 0; e < 8; ++e) y[e] = v[e] * rstd * nwv[e] * sigmoidf_(o[e]);
            u32x2 w;
            { int a = __builtin_amdgcn_cvt_pk_fp8_f32(clamp8(y[0] * XQ_SCALE), clamp8(y[1] * XQ_SCALE), 0, false); a = __builtin_amdgcn_cvt_pk_fp8_f32(clamp8(y[2] * XQ_SCALE), clamp8(y[3] * XQ_SCALE), a, true);
              int b = __builtin_amdgcn_cvt_pk_fp8_f32(clamp8(y[4] * XQ_SCALE), clamp8(y[5] * XQ_SCALE), 0, false); b = __builtin_amdgcn_cvt_pk_fp8_f32(clamp8(y[6] * XQ_SCALE), clamp8(y[7] * XQ_SCALE), b, true); w.x = (unsigned)a; w.y = (unsigned)b; }
            *(u32x2*)(HB + (size_t)tok * DM + h * 512 + 8 * lane) = w; }
    }
}

__device__ void ph_ln_rows(const bf16_t* pre, const float* w, const float* bb, bf16_t* outb, unsigned char* outq) {
    const int wid = threadIdx.x >> 6, lane = threadIdx.x & 63;
    for (int tok = blockIdx.x * 8 + wid; tok < T_TOK; tok += gridDim.x * 8) {
        float v[4][8]; float s = 0.f;
#pragma unroll
        for (int j = 0; j < 4; ++j) { const u32x4 r = *(const u32x4*)(pre + (size_t)tok * DM + 512 * j + 8 * lane);
            v[j][0] = bflo(r.x); v[j][1] = bfhi(r.x); v[j][2] = bflo(r.y); v[j][3] = bfhi(r.y); v[j][4] = bflo(r.z); v[j][5] = bfhi(r.z); v[j][6] = bflo(r.w); v[j][7] = bfhi(r.w);
#pragma unroll
            for (int e = 0; e < 8; ++e) s += v[j][e]; }
        const float mean = wsum(s) * (1.0f / 2048.0f);
        float q = 0.f;
#pragma unroll
        for (int j = 0; j < 4; ++j)
#pragma unroll
            for (int e = 0; e < 8; ++e) { v[j][e] -= mean; q += v[j][e] * v[j][e]; }
        const float rstd = rsqrtf(wsum(q) * (1.0f / 2048.0f) + LN_EPS);
#pragma unroll
        for (int j = 0; j < 4; ++j) { const int c = 512 * j + 8 * lane;
            const float4 w0 = *(const float4*)(w + c), w1 = *(const float4*)(w + c + 4), b0 = *(const float4*)(bb + c), b1 = *(const float4*)(bb + c + 4);
            float4 y0, y1;
            y0.x = v[j][0] * rstd * w0.x + b0.x; y0.y = v[j][1] * rstd * w0.y + b0.y; y0.z = v[j][2] * rstd * w0.z + b0.z; y0.w = v[j][3] * rstd * w0.w + b0.w;
            y1.x = v[j][4] * rstd * w1.x + b1.x; y1.y = v[j][5] * rstd * w1.y + b1.y; y1.z = v[j][6] * rstd * w1.z + b1.z; y1.w = v[j][7] * rstd * w1.w + b1.w;
            u32x4 pk; pk.x = cvt_pk_bf16(y0.x, y0.y); pk.y = cvt_pk_bf16(y0.z, y0.w); pk.z = cvt_pk_bf16(y1.x, y1.y); pk.w = cvt_pk_bf16(y1.z, y1.w);
            *(u32x4*)(outb + (size_t)tok * DM + c) = pk;
            if (outq) { int a = __builtin_amdgcn_cvt_pk_fp8_f32(clamp8(y0.x * XQ_SCALE), clamp8(y0.y * XQ_SCALE), 0, false); a = __builtin_amdgcn_cvt_pk_fp8_f32(clamp8(y0.z * XQ_SCALE), clamp8(y0.w * XQ_SCALE), a, true);
                int b = __builtin_amdgcn_cvt_pk_fp8_f32(clamp8(y1.x * XQ_SCALE), clamp8(y1.y * XQ_SCALE), 0, false); b = __builtin_amdgcn_cvt_pk_fp8_f32(clamp8(y1.z * XQ_SCALE), clamp8(y1.w * XQ_SCALE), b, true);
                u32x2 q8; q8.x = (unsigned)a; q8.y = (unsigned)b; *(u32x2*)(outq + (size_t)tok * DM + c) = q8; } }
    }
}

__device__ __forceinline__ void xattn_item(const Params& p, unsigned char* lds_, int b, int h, int qblk) {
    constexpr int KLD = 72, VLD = 264;
    bf16_t* Ks = (bf16_t*)lds_;
    bf16_t* Vs = Ks + 256 * KLD;
    const int tid = threadIdx.x, wid = tid >> 6, lane = tid & 63, n = lane & 15, g = lane >> 4;
    const size_t tokq = (size_t)b * SEQ + qblk * 128 + 16 * wid + n;
    const bf16_t* Qp = (const bf16_t*)(p.ws + OFF_QX) + tokq * DM + h * 512;
    const bf16_t* Kc = (const bf16_t*)(p.ws + OFF_KC) + (size_t)b * 256 * DM + h * 512;
    const bf16_t* VcT = (const bf16_t*)(p.ws + OFF_VCT) + (size_t)(h * 512) * 1024 + b * 256;
    f32x4 S[16];
#pragma unroll
    for (int i = 0; i < 16; ++i) S[i] = (f32x4){0.f, 0.f, 0.f, 0.f};
    u32x4 kreg[4]; bf16x8 qnext[2];
#pragma unroll
    for (int i = 0; i < 4; ++i) { const int q = tid + 512 * i, row = q >> 3, cc = q & 7; kreg[i] = *(const u32x4*)(Kc + (size_t)row * DM + cc * 8); }
#pragma unroll
    for (int ks = 0; ks < 2; ++ks) qnext[ks] = *(const bf16x8*)(Qp + ks * 32 + g * 8);
    for (int dc = 0; dc < 8; ++dc) {
        __syncthreads();
#pragma unroll
        for (int i = 0; i < 4; ++i) { const int q = tid + 512 * i, row = q >> 3, cc = q & 7; *(u32x4*)(Ks + row * KLD + cc * 8) = kreg[i]; }
        bf16x8 qf[2]; qf[0] = qnext[0]; qf[1] = qnext[1];
        __syncthreads();
        if (dc + 1 < 8) {
#pragma unroll
            for (int i = 0; i < 4; ++i) { const int q = tid + 512 * i, row = q >> 3, cc = q & 7; kreg[i] = *(const u32x4*)(Kc + (size_t)row * DM + (dc + 1) * 64 + cc * 8); }
#pragma unroll
            for (int ks = 0; ks < 2; ++ks) qnext[ks] = *(const bf16x8*)(Qp + (dc + 1) * 64 + ks * 32 + g * 8);
        }
#pragma unroll
        for (int kt = 0; kt < 16; ++kt)
#pragma unroll
            for (int ks = 0; ks < 2; ++ks) { const bf16x8 a = *(const bf16x8*)(Ks + (16 * kt + n) * KLD + ks * 32 + g * 8);
                S[kt] = __builtin_amdgcn_mfma_f32_16x16x32_bf16(a, qf[ks], S[kt], 0, 0, 0); }
    }
    const float scale = 0.04419417382415922f;
    float mx = -INFINITY;
#pragma unroll
    for (int kt = 0; kt < 16; ++kt)
#pragma unroll
        for (int j = 0; j < 4; ++j) { S[kt][j] *= scale; mx = fmaxf(mx, S[kt][j]); }
    mx = fmaxf(mx, __shfl_xor(mx, 16)); mx = fmaxf(mx, __shfl_xor(mx, 32));
    float l = 0.f;
#pragma unroll
    for (int kt = 0; kt < 16; ++kt)
#pragma unroll
        for (int j = 0; j < 4; ++j) { const float e = __expf(S[kt][j] - mx); S[kt][j] = e; l += e; }
    l += __shfl_xor(l, 16); l += __shfl_xor(l, 32);
    const float inv = 1.0f / l;
    bf16x8 pf[8];
#pragma unroll
    for (int kk = 0; kk < 8; ++kk) { u32x4 w; w.x = cvt_pk_bf16(S[2 * kk][0], S[2 * kk][1]); w.y = cvt_pk_bf16(S[2 * kk][2], S[2 * kk][3]);
        w.z = cvt_pk_bf16(S[2 * kk + 1][0], S[2 * kk + 1][1]); w.w = cvt_pk_bf16(S[2 * kk + 1][2], S[2 * kk + 1][3]); pf[kk] = __builtin_bit_cast(bf16x8, w); }
    bf16_t* op = (bf16_t*)(p.ws + OFF_OB) + tokq * DM + h * 512 + 4 * g;
    u32x4 vreg[8];
#pragma unroll
    for (int i = 0; i < 8; ++i) { const int q = tid + 512 * i, d = q >> 5, cc = q & 31; vreg[i] = *(const u32x4*)(VcT + (size_t)d * 1024 + cc * 8); }
    for (int dvc = 0; dvc < 4; ++dvc) {
        __syncthreads();
#pragma unroll
        for (int i = 0; i < 8; ++i) { const int q = tid + 512 * i, d = q >> 5, cc = q & 31; *(u32x4*)(Vs + d * VLD + cc * 8) = vreg[i]; }
        __syncthreads();
        if (dvc + 1 < 4) {
#pragma unroll
            for (int i = 0; i < 8; ++i) { const int q = tid + 512 * i, d = q >> 5, cc = q & 31; vreg[i] = *(const u32x4*)(VcT + (size_t)((dvc + 1) * 128 + d) * 1024 + cc * 8); }
        }
        f32x4 O[8];
#pragma unroll
        for (int dt = 0; dt < 8; ++dt) { O[dt] = (f32x4){0.f, 0.f, 0.f, 0.f};
#pragma unroll
            for (int kk = 0; kk < 8; ++kk) { const bf16_t* vp = Vs + (16 * dt + n) * VLD + 32 * kk + 4 * g;
                const u32x2 lo = *(const u32x2*)vp, hi = *(const u32x2*)(vp + 16); u32x4 w; w.x = lo.x; w.y = lo.y; w.z = hi.x; w.w = hi.y;
                O[dt] = __builtin_amdgcn_mfma_f32_16x16x32_bf16(__builtin_bit_cast(bf16x8, w), pf[kk], O[dt], 0, 0, 0); } }
        { const float sv = inv * OQ_SCALE; unsigned char* op8 = p.ws + OFF_OB + tokq * DM + h * 512 + 4 * g + dvc * 128;
#pragma unroll
          for (int dt = 0; dt < 8; ++dt) { int a = __builtin_amdgcn_cvt_pk_fp8_f32(clamp8(O[dt][0] * sv), clamp8(O[dt][1] * sv), 0, false); a = __builtin_amdgcn_cvt_pk_fp8_f32(clamp8(O[dt][2] * sv), clamp8(O[dt][3] * sv), a, true);
              *(int*)(op8 + 16 * dt) = a; } }
    }
}

__device__ __forceinline__ unsigned ordf(float f) { const unsigned u = __float_as_uint(f); return (u & 0x80000000u) ? ~u : (u | 0x80000000u); }

__device__ __forceinline__ unsigned dpp_max_u32(unsigned v) {
    unsigned t;
    t = (unsigned)__builtin_amdgcn_update_dpp(0, (int)v, 0x111, 0xf, 0xf, true); v = v > t ? v : t;
    t = (unsigned)__builtin_amdgcn_update_dpp(0, (int)v, 0x112, 0xf, 0xf, true); v = v > t ? v : t;
    t = (unsigned)__builtin_amdgcn_update_dpp(0, (int)v, 0x114, 0xf, 0xf, true); v = v > t ? v : t;
    t = (unsigned)__builtin_amdgcn_update_dpp(0, (int)v, 0x118, 0xf, 0xf, true); v = v > t ? v : t;
    t = (unsigned)__builtin_amdgcn_update_dpp(0, (int)v, 0x142, 0xa, 0xf, false); v = v > t ? v : t;
    t = (unsigned)__builtin_amdgcn_update_dpp(0, (int)v, 0x143, 0xc, 0xf, false); v = v > t ? v : t;
    return (unsigned)__builtin_amdgcn_readlane((int)v, 63);
}
__device__ __forceinline__ float rdlane_f(float v, int l) { return __int_as_float(__builtin_amdgcn_readlane(__float_as_int(v), l)); }

__device__ __forceinline__ void split_bf16x8(const float4 a, const float4 b, bf16x8& hi, bf16x8& lo) {
    u32x4 h, l;
    h.x = cvt_pk_bf16(a.x, a.y); h.y = cvt_pk_bf16(a.z, a.w); h.z = cvt_pk_bf16(b.x, b.y); h.w = cvt_pk_bf16(b.z, b.w);
    l.x = cvt_pk_bf16(a.x - bflo(h.x), a.y - bfhi(h.x)); l.y = cvt_pk_bf16(a.z - bflo(h.y), a.w - bfhi(h.y));
    l.z = cvt_pk_bf16(b.x - bflo(h.z), b.y - bfhi(h.z)); l.w = cvt_pk_bf16(b.z - bflo(h.w), b.w - bfhi(h.w));
    hi = __builtin_bit_cast(bf16x8, h); lo = __builtin_bit_cast(bf16x8, l);
}

__device__ __forceinline__ float unordf(unsigned w) { return __uint_as_float((w & 0x80000000u) ? (w & 0x7fffffffu) : ~w); }
__device__ __forceinline__ unsigned umax_(unsigned a, unsigned b) { return a > b ? a : b; }
__device__ __forceinline__ unsigned xg_max(unsigned m) {
    m = umax_(m, (unsigned)__shfl_xor((int)m, 16)); m = umax_(m, (unsigned)__shfl_xor((int)m, 32)); return m; }
__device__ __forceinline__ int cndm(int f, int t, unsigned long long m) { int r; asm("v_cndmask_b32 %0, %1, %2, %3" : "=v"(r) : "v"(f), "v"(t), "s"(m)); return r; }
__device__ __forceinline__ int sel16(const int (&t)[16], int i) {
    const unsigned long long m0 = __builtin_amdgcn_ballot_w64((i & 1) != 0), m1 = __builtin_amdgcn_ballot_w64((i & 2) != 0), m2 = __builtin_amdgcn_ballot_w64((i & 4) != 0), m3 = __builtin_amdgcn_ballot_w64((i & 8) != 0);
    int a[8];
#pragma unroll
    for (int k = 0; k < 8; ++k) a[k] = cndm(t[2 * k], t[2 * k + 1], m0);
    int c[4];
#pragma unroll
    for (int k = 0; k < 4; ++k) c[k] = cndm(a[2 * k], a[2 * k + 1], m1);
    const int d0 = cndm(c[0], c[1], m2), d1 = cndm(c[2], c[3], m2);
    return cndm(d0, d1, m3); }

__device__ void ph_peer_score(const Params& p, unsigned char* lds_) {
    constexpr int KLD = 136;
    const int tid = threadIdx.x, wid = tid >> 6, lane = tid & 63, n = lane & 15, g = lane >> 4;
    bf16_t* KH = (bf16_t*)lds_;
    bf16_t* KL = KH + 2 * 128 * KLD;
    const float* QP = (const float*)(p.ws + OFF_QP);
    int* IDX = (int*)(p.ws + OFF_IDX); float* GG = (float*)(p.ws + OFF_G);
    for (int unit = blockIdx.x; unit < 256; unit += gridDim.x) {
        const int h = unit & 7, chunk = unit >> 3;
        __syncthreads();
        { float4 kv[16];
#pragma unroll
          for (int it = 0; it < 16; ++it) kv[it] = *(const float4*)(p.sub_keys + (size_t)h * 32768 + 4 * (tid + 512 * it));
#pragma unroll
          for (int it = 0; it < 16; ++it) { const int e = 4 * (tid + 512 * it), pn = e >> 7, d = e & 127;
              const unsigned h0 = cvt_pk_bf16(kv[it].x, kv[it].y), h1 = cvt_pk_bf16(kv[it].z, kv[it].w);
              const unsigned l0 = cvt_pk_bf16(kv[it].x - bflo(h0), kv[it].y - bfhi(h0)), l1 = cvt_pk_bf16(kv[it].z - bflo(h1), kv[it].w - bfhi(h1));
              u32x2 hw; hw.x = h0; hw.y = h1; u32x2 lw; lw.x = l0; lw.y = l1;
              *(u32x2*)(KH + pn * KLD + d) = hw; *(u32x2*)(KL + pn * KLD + d) = lw; } }
        __syncthreads();
        for (int grp = 0; grp < 2; ++grp) {
            const int tok = chunk * 256 + wid * 32 + grp * 16 + n;
            unsigned pk[2][32];
#pragma unroll
            for (int pp = 0; pp < 2; ++pp) {
                bf16x8 qh[4], ql[4];
                const float* qp = QP + (size_t)tok * DM + h * 256 + pp * 128 + g * 8;
#pragma unroll
                for (int ks = 0; ks < 4; ++ks) split_bf16x8(*(const float4*)(qp + ks * 32), *(const float4*)(qp + ks * 32 + 4), qh[ks], ql[ks]);
#pragma unroll
                for (int kt = 0; kt < 8; ++kt) { f32x4 acc = (f32x4){0.f, 0.f, 0.f, 0.f};
#pragma unroll
                    for (int ks = 0; ks < 4; ++ks) { const int off = (pp * 128 + 16 * kt + n) * KLD + ks * 32 + g * 8;
                        const bf16x8 ah = *(const bf16x8*)(KH + off), al = *(const bf16x8*)(KL + off);
                        acc = __builtin_amdgcn_mfma_f32_16x16x32_bf16(al, qh[ks], acc, 0, 0, 0);
                        acc = __builtin_amdgcn_mfma_f32_16x16x32_bf16(ah, ql[ks], acc, 0, 0, 0);
                        acc = __builtin_amdgcn_mfma_f32_16x16x32_bf16(ah, qh[ks], acc, 0, 0, 0); }
#pragma unroll
                    for (int j = 0; j < 4; ++j) pk[pp][kt * 4 + j] = (ordf(acc[j]) & ~127u) | (unsigned)(127 - (16 * kt + 4 * g + j)); }
            }
            unsigned tw[2][16];
#pragma unroll
            for (int r = 0; r < 16; ++r) {
#pragma unroll
                for (int pp = 0; pp < 2; ++pp) { unsigned m = pk[pp][0];
#pragma unroll
                    for (int i = 1; i < 32; ++i) m = umax_(m, pk[pp][i]);
                    m = xg_max(m); tw[pp][r] = m;
#pragma unroll
                    for (int i = 0; i < 32; ++i) pk[pp][i] = (pk[pp][i] == m) ? 0u : pk[pp][i]; }
            }
            float av[16]; int ti0[16], ti1[16];
#pragma unroll
            for (int i = 0; i < 16; ++i) { av[i] = unordf(tw[0][i] & ~127u); ti0[i] = 127 - (int)(tw[0][i] & 127u); ti1[i] = 127 - (int)(tw[1][i] & 127u); }
            float bv[4];
#pragma unroll
            for (int jj = 0; jj < 4; ++jj) { const unsigned t = g == 0 ? tw[1][4 * jj] : g == 1 ? tw[1][4 * jj + 1] : g == 2 ? tw[1][4 * jj + 2] : tw[1][4 * jj + 3]; bv[jj] = unordf(t & ~127u); }
            unsigned cp[21];
#pragma unroll
            for (int i = 0; i < 16; ++i) cp[i] = (ordf(av[i] + bv[0]) & ~255u) | (unsigned)(255 - (16 * i + g));
#pragma unroll
            for (int i = 0; i < 3; ++i) cp[16 + i] = (ordf(av[i] + bv[1]) & ~255u) | (unsigned)(255 - (16 * i + 4 + g));
            cp[19] = (ordf(av[0] + bv[2]) & ~255u) | (unsigned)(255 - (8 + g));
            cp[20] = (ordf(av[0] + bv[3]) & ~255u) | (unsigned)(255 - (12 + g));
            unsigned cw[16];
#pragma unroll
            for (int r = 0; r < 16; ++r) { unsigned m = cp[0];
#pragma unroll
                for (int i = 1; i < 21; ++i) m = umax_(m, cp[i]);
                m = xg_max(m); cw[r] = m;
#pragma unroll
                for (int i = 0; i < 21; ++i) cp[i] = (cp[i] == m) ? 0u : cp[i]; }
            float sv[16]; int ev[16]; float mx = -INFINITY;
#pragma unroll
            for (int r = 0; r < 16; ++r) { const int cid = 255 - (int)(cw[r] & 255u); ev[r] = sel16(ti0, cid >> 4) * 128 + sel16(ti1, cid & 15); sv[r] = unordf(cw[r] & ~255u); mx = fmaxf(mx, sv[r]); }
            float sm = 0.f;
#pragma unroll
            for (int r = 0; r < 16; ++r) { sv[r] = __expf(sv[r] - mx); sm += sv[r]; }
            const float rs = 1.0f / sm;
            if (g == 0) {
                int* ip = IDX + (size_t)tok * 128 + h * 16; float* gp = GG + (size_t)tok * 128 + h * 16;
#pragma unroll
                for (int r4 = 0; r4 < 4; ++r4) { *(int4*)(ip + 4 * r4) = make_int4(ev[4 * r4], ev[4 * r4 + 1], ev[4 * r4 + 2], ev[4 * r4 + 3]);
                    *(float4*)(gp + 4 * r4) = make_float4(sv[4 * r4] * rs, sv[4 * r4 + 1] * rs, sv[4 * r4 + 2] * rs, sv[4 * r4 + 3] * rs); }
            }
        }
    }
    __syncthreads();
}

constexpr float U_SCALE = 256.0f, V_SCALE = 16.0f;
__device__ __forceinline__ float dot16(const u32x4 r, const float* x) {
    float d = 0.f;
#pragma unroll
    for (int k = 0; k < 4; ++k) { const f32x2 lo = __builtin_amdgcn_cvt_pk_f32_fp8((int)r[k], false), hi = __builtin_amdgcn_cvt_pk_f32_fp8((int)r[k], true);
        d += x[4 * k] * lo.x + x[4 * k + 1] * lo.y + x[4 * k + 2] * hi.x + x[4 * k + 3] * hi.y; }
    return d; }
__device__ __forceinline__ void axpy16(float* a, const float hv, const u32x4 r) {
#pragma unroll
    for (int k = 0; k < 4; ++k) { const f32x2 lo = __builtin_amdgcn_cvt_pk_f32_fp8((int)r[k], false), hi = __builtin_amdgcn_cvt_pk_f32_fp8((int)r[k], true);
        a[4 * k] += hv * lo.x; a[4 * k + 1] += hv * lo.y; a[4 * k + 2] += hv * hi.x; a[4 * k + 3] += hv * hi.y; } }

__device__ void ph_peer_gather(const Params& p) {
    constexpr int UN = 4;
    const int wid = threadIdx.x >> 6, lane = threadIdx.x & 63;
    const bf16_t* X2 = (const bf16_t*)(p.ws + OFF_X2B);
    const int* IDX = (const int*)(p.ws + OFF_IDX); const float* GG = (const float*)(p.ws + OFF_G);
    const unsigned char* UB = p.ws + OFF_UB; const unsigned char* VB = p.ws + OFF_VB;
    const float* lw = p.ln_w + 2 * DM; const float* lb = p.ln_b + 2 * DM;
    for (int tok = blockIdx.x * 8 + wid; tok < T_TOK; tok += gridDim.x * 8) {
        int lo16 = 16 * lane; asm volatile("" : "+v"(lo16));
        float xv[2][16];
#pragma unroll
        for (int j = 0; j < 2; ++j)
#pragma unroll
            for (int k = 0; k < 2; ++k) { const u32x4 a = *(const u32x4*)(X2 + (size_t)tok * DM + 1024 * j + lo16 + 8 * k);
                xv[j][8 * k] = bflo(a.x); xv[j][8 * k + 1] = bfhi(a.x); xv[j][8 * k + 2] = bflo(a.y); xv[j][8 * k + 3] = bfhi(a.y); xv[j][8 * k + 4] = bflo(a.z); xv[j][8 * k + 5] = bfhi(a.z); xv[j][8 * k + 6] = bflo(a.w); xv[j][8 * k + 7] = bfhi(a.w); }
        int idr[2]; float gr[2], ar[2] = {0.f, 0.f};
        idr[0] = IDX[(size_t)tok * 128 + lane]; idr[1] = IDX[(size_t)tok * 128 + 64 + lane];
        gr[0] = GG[(size_t)tok * 128 + lane]; gr[1] = GG[(size_t)tok * 128 + 64 + lane];
#pragma unroll
        for (int half = 0; half < 2; ++half) {
#pragma unroll 1
            for (int e = 0; e < 64; e += UN) {
                u32x4 r[UN][2];
#pragma unroll
                for (int u = 0; u < UN; ++u) { const int id = __builtin_amdgcn_readlane(idr[half], e + u); const unsigned char* rp = UB + (size_t)id * DM + lo16;
                    r[u][0] = *(const u32x4*)rp; r[u][1] = *(const u32x4*)(rp + 1024); }
#pragma unroll
                for (int u = 0; u < UN; ++u) { float d = dot16(r[u][0], xv[0]) + dot16(r[u][1], xv[1]);
                    d = wsum(d);
                    if (lane == e + u) ar[half] = d * (1.0f / U_SCALE);
                    __builtin_amdgcn_sched_barrier(0); }
            }
        }
        float hr[2];
#pragma unroll
        for (int half = 0; half < 2; ++half) hr[half] = 0.5f * ar[half] * (1.0f + erff(ar[half] * 0.70710678118654752f)) * gr[half] * (1.0f / V_SCALE);
        float acc[2][16];
#pragma unroll
        for (int j = 0; j < 2; ++j)
#pragma unroll
            for (int e = 0; e < 16; ++e) acc[j][e] = 0.f;
#pragma unroll
        for (int half = 0; half < 2; ++half) {
#pragma unroll 1
            for (int e = 0; e < 64; e += UN) {
                u32x4 r[UN][2]; float hv[UN];
#pragma unroll
                for (int u = 0; u < UN; ++u) { const int id = __builtin_amdgcn_readlane(idr[half], e + u); hv[u] = __int_as_float(__builtin_amdgcn_readlane(__float_as_int(hr[half]), e + u));
                    const unsigned char* rp = VB + (size_t)id * DM + lo16;
                    r[u][0] = *(const u32x4*)rp; r[u][1] = *(const u32x4*)(rp + 1024); }
#pragma unroll
                for (int u = 0; u < UN; ++u) { axpy16(acc[0], hv[u], r[u][0]); axpy16(acc[1], hv[u], r[u][1]); __builtin_amdgcn_sched_barrier(0); }
            }
        }
        asm volatile("" : "+v"(lo16));
        float s = 0.f;
#pragma unroll
        for (int j = 0; j < 2; ++j)
#pragma unroll
            for (int k = 0; k < 2; ++k) { const u32x4 a = *(const u32x4*)(X2 + (size_t)tok * DM + 1024 * j + lo16 + 8 * k);
                acc[j][8 * k] += DN_ALPHA * bflo(a.x); acc[j][8 * k + 1] += DN_ALPHA * bfhi(a.x); acc[j][8 * k + 2] += DN_ALPHA * bflo(a.y); acc[j][8 * k + 3] += DN_ALPHA * bfhi(a.y);
                acc[j][8 * k + 4] += DN_ALPHA * bflo(a.z); acc[j][8 * k + 5] += DN_ALPHA * bfhi(a.z); acc[j][8 * k + 6] += DN_ALPHA * bflo(a.w); acc[j][8 * k + 7] += DN_ALPHA * bfhi(a.w);
#pragma unroll
                for (int e = 0; e < 8; ++e) s += acc[j][8 * k + e]; }
        const float mean = wsum(s) * (1.0f / 2048.0f);
        float q = 0.f;
#pragma unroll
        for (int j = 0; j < 2; ++j)
#pragma unroll
            for (int e = 0; e < 16; ++e) { acc[j][e] -= mean; q += acc[j][e] * acc[j][e]; }
        const float rstd = rsqrtf(wsum(q) * (1.0f / 2048.0f) + LN_EPS);
#pragma unroll
        for (int j = 0; j < 2; ++j)
#pragma unroll
            for (int k = 0; k < 4; ++k) { const int c = 1024 * j + lo16 + 4 * k;
                const float4 w0 = *(const float4*)(lw + c), b0 = *(const float4*)(lb + c);
                float4 y0;
                y0.x = acc[j][4 * k] * rstd * w0.x + b0.x; y0.y = acc[j][4 * k + 1] * rstd * w0.y + b0.y; y0.z = acc[j][4 * k + 2] * rstd * w0.z + b0.z; y0.w = acc[j][4 * k + 3] * rstd * w0.w + b0.w;
                *(float4*)(p.out + (size_t)tok * DM + c) = y0; }
    }
}

typedef float f32x16 __attribute__((ext_vector_type(16)));
typedef float f32x32 __attribute__((ext_vector_type(32)));
typedef unsigned u32x6 __attribute__((ext_vector_type(6)));
constexpr float U6_SCALE = 64.0f, V6_SCALE = 8.0f;
constexpr int ROW6 = 1536;
__device__ __forceinline__ float clamp6(float x) { return fminf(fmaxf(x, -7.5f), 7.5f); }
__device__ void cvt_f32_fp6(const float* src, unsigned char* dst, size_t n32, float scale, unsigned char* lds_) {
    float* buf = (float*)lds_ + threadIdx.x * 33;
    int pi[32];
    { f32x16 pa, pb;
#pragma unroll
      for (int i = 0; i < 16; ++i) { pa[i] = (float)(i & 7); pb[i] = (float)((16 + i) & 7); }
      const f32x32 d1 = __builtin_amdgcn_cvt_scalef32_pk32_f32_fp6(__builtin_amdgcn_cvt_scalef32_2xpk16_fp6_f32(pa, pb, 1.0f), 1.0f);
#pragma unroll
      for (int i = 0; i < 16; ++i) { pa[i] = (float)(i >> 3); pb[i] = (float)((16 + i) >> 3); }
      const f32x32 d2 = __builtin_amdgcn_cvt_scalef32_pk32_f32_fp6(__builtin_amdgcn_cvt_scalef32_2xpk16_fp6_f32(pa, pb, 1.0f), 1.0f);
#pragma unroll
      for (int j = 0; j < 32; ++j) pi[j] = ((int)(d2[j] + 0.5f)) * 8 + (int)(d1[j] + 0.5f); }
    for (size_t i = (size_t)blockIdx.x * blockDim.x + threadIdx.x; i < n32; i += (size_t)gridDim.x * blockDim.x) {
        float4 v[8];
#pragma unroll
        for (int k = 0; k < 8; ++k) v[k] = *(const float4*)(src + i * 32 + 4 * k);
        asm volatile("s_waitcnt lgkmcnt(0)" ::: "memory");
#pragma unroll
        for (int k = 0; k < 8; ++k) { buf[pi[4 * k]] = clamp6(v[k].x * scale); buf[pi[4 * k + 1]] = clamp6(v[k].y * scale); buf[pi[4 * k + 2]] = clamp6(v[k].z * scale); buf[pi[4 * k + 3]] = clamp6(v[k].w * scale); }
        asm volatile("s_waitcnt lgkmcnt(0)" ::: "memory");
        f32x16 a, b;
#pragma unroll
        for (int k = 0; k < 16; ++k) { a[k] = buf[k]; b[k] = buf[16 + k]; }
        const u32x6 q = __builtin_amdgcn_cvt_scalef32_2xpk16_fp6_f32(a, b, 1.0f);
        u32x2* dp = (u32x2*)(dst + i * 24);
        u32x2 t; t.x = q[0]; t.y = q[1]; dp[0] = t; t.x = q[2]; t.y = q[3]; dp[1] = t; t.x = q[4]; t.y = q[5]; dp[2] = t; }
}
__device__ __forceinline__ u32x6 ld_row6(const unsigned char* rp) { const u32x2 a = *(const u32x2*)rp, b = *(const u32x2*)(rp + 8), c = *(const u32x2*)(rp + 16); u32x6 r; r[0] = a.x; r[1] = a.y; r[2] = b.x; r[3] = b.y; r[4] = c.x; r[5] = c.y; return r; }

__device__ void ph_peer_gather6(const Params& p, unsigned char* lds_) {
    constexpr int UN = 8, UN2 = 16;
    const int wid = threadIdx.x >> 6, lane = threadIdx.x & 63;
    const bf16_t* X2 = (const bf16_t*)(p.ws + OFF_X2B);
    const int* IDX = (const int*)(p.ws + OFF_IDX); const float* GG = (const float*)(p.ws + OFF_G);
    const unsigned char* UB = p.ws + OFF_UB; const unsigned char* VB = p.ws + OFF_VB;
    const float* lw = p.ln_w + 2 * DM; const float* lb = p.ln_b + 2 * DM;
    const bool lockstep = (T_TOK % (gridDim.x * 8)) == 0;
    for (int tok = blockIdx.x * 8 + wid; tok < T_TOK; tok += gridDim.x * 8) {
        int lo = lane; asm volatile("" : "+v"(lo));
        float xv[32];
#pragma unroll
        for (int k = 0; k < 4; ++k) { const u32x4 a = *(const u32x4*)(X2 + (size_t)tok * DM + 32 * lo + 8 * k);
            xv[8 * k] = bflo(a.x); xv[8 * k + 1] = bfhi(a.x); xv[8 * k + 2] = bflo(a.y); xv[8 * k + 3] = bfhi(a.y); xv[8 * k + 4] = bflo(a.z); xv[8 * k + 5] = bfhi(a.z); xv[8 * k + 6] = bflo(a.w); xv[8 * k + 7] = bfhi(a.w); }
        int idr[2]; float gr[2], ar[2] = {0.f, 0.f};
        idr[0] = IDX[(size_t)tok * 128 + lane]; idr[1] = IDX[(size_t)tok * 128 + 64 + lane];
        gr[0] = GG[(size_t)tok * 128 + lane]; gr[1] = GG[(size_t)tok * 128 + 64 + lane];
        {
            int rk0 = 0, rk1 = 0;
            const int rot = (int)(blockIdx.x & 7) * 2048;
            const int k0v = (idr[0] - rot) & 16383, k1v = (idr[1] - rot) & 16383;
#pragma unroll 4
            for (int e = 0; e < 64; ++e) { const int a = __builtin_amdgcn_readlane(k0v, e), b2 = __builtin_amdgcn_readlane(k1v, e);
                rk0 += (int)((a < k0v) || (a == k0v && e < lane)) + (int)(b2 < k0v);
                rk1 += (int)(a <= k1v) + (int)((b2 < k1v) || (b2 == k1v && e < lane)); }
            int* sidx = (int*)(lds_ + wid * 1024); float* sgv = (float*)(sidx + 128);
            asm volatile("s_waitcnt lgkmcnt(0)" ::: "memory");
            sidx[rk0] = idr[0]; sidx[rk1] = idr[1]; sgv[rk0] = gr[0]; sgv[rk1] = gr[1];
            asm volatile("s_waitcnt lgkmcnt(0)" ::: "memory");
            idr[0] = sidx[lane]; idr[1] = sidx[64 + lane]; gr[0] = sgv[lane]; gr[1] = sgv[64 + lane];
            asm volatile("s_waitcnt lgkmcnt(0)" ::: "memory");
        }
#pragma unroll
        for (int half = 0; half < 2; ++half) {
#pragma unroll 1
            for (int e = 0; e < 64; e += UN) {
                if (lockstep && (e & 15) == 0) __syncthreads();
                u32x6 r[UN];
#pragma unroll
                for (int u = 0; u < UN; ++u) { const int id = __builtin_amdgcn_readlane(idr[half], e + u); r[u] = ld_row6(UB + (size_t)id * ROW6 + 24 * lo); }
#pragma unroll
                for (int u = 0; u < UN; ++u) { const f32x32 d = __builtin_amdgcn_cvt_scalef32_pk32_f32_fp6(r[u], 1.0f); f32x2 sA = (f32x2){0.f, 0.f}, sB = (f32x2){0.f, 0.f};
#pragma unroll
                    for (int i = 0; i < 16; i += 2) {
                        sA = __builtin_elementwise_fma((f32x2){d[2 * i], d[2 * i + 1]}, (f32x2){xv[2 * i], xv[2 * i + 1]}, sA);
                        sB = __builtin_elementwise_fma((f32x2){d[2 * i + 2], d[2 * i + 3]}, (f32x2){xv[2 * i + 2], xv[2 * i + 3]}, sB); }
                    const f32x2 sS = sA + sB;
                    const float t = wsum(sS.x + sS.y);
                    if (lane == e + u) ar[half] = t * (1.0f / U6_SCALE);
                    __builtin_amdgcn_sched_barrier(0); }
            }
        }
        float hr[2];
#pragma unroll
        for (int half = 0; half < 2; ++half) hr[half] = 0.5f * ar[half] * (1.0f + erff(ar[half] * 0.70710678118654752f)) * gr[half] * (1.0f / V6_SCALE);
        float acc[32];
#pragma unroll
        for (int i = 0; i < 32; ++i) acc[i] = 0.f;
#pragma unroll
        for (int half = 0; half < 2; ++half) {
#pragma unroll 1
            for (int e = 0; e < 64; e += UN2) {
                if (lockstep && (e & 15) == 0) __syncthreads();
                u32x6 r[UN2]; float hv[UN2];
#pragma unroll
                for (int u = 0; u < UN2; ++u) { const int id = __builtin_amdgcn_readlane(idr[half], e + u); hv[u] = __int_as_float(__builtin_amdgcn_readlane(__float_as_int(hr[half]), e + u));
                    r[u] = ld_row6(VB + (size_t)id * ROW6 + 24 * lo); }
#pragma unroll
                for (int u = 0; u < UN2; ++u) { const f32x32 d = __builtin_amdgcn_cvt_scalef32_pk32_f32_fp6(r[u], 1.0f); const f32x2 h2 = (f32x2){hv[u], hv[u]};
#pragma unroll
                    for (int i = 0; i < 16; ++i) { const f32x2 a2 = __builtin_elementwise_fma(h2, (f32x2){d[2 * i], d[2 * i + 1]}, (f32x2){acc[2 * i], acc[2 * i + 1]}); acc[2 * i] = a2.x; acc[2 * i + 1] = a2.y; }
                    __builtin_amdgcn_sched_barrier(0); }
            }
        }
        asm volatile("" : "+v"(lo));
        float s = 0.f;
#pragma unroll
        for (int k = 0; k < 4; ++k) { const u32x4 a = *(const u32x4*)(X2 + (size_t)tok * DM + 32 * lo + 8 * k);
            acc[8 * k] += DN_ALPHA * bflo(a.x); acc[8 * k + 1] += DN_ALPHA * bfhi(a.x); acc[8 * k + 2] += DN_ALPHA * bflo(a.y); acc[8 * k + 3] += DN_ALPHA * bfhi(a.y);
            acc[8 * k + 4] += DN_ALPHA * bflo(a.z); acc[8 * k + 5] += DN_ALPHA * bfhi(a.z); acc[8 * k + 6] += DN_ALPHA * bflo(a.w); acc[8 * k + 7] += DN_ALPHA * bfhi(a.w); }
#pragma unroll
        for (int i = 0; i < 32; ++i) s += acc[i];
        const float mean = wsum(s) * (1.0f / 2048.0f);
        float q = 0.f;
#pragma unroll
        for (int i = 0; i < 32; ++i) { acc[i] -= mean; q += acc[i] * acc[i]; }
        const float rstd = rsqrtf(wsum(q) * (1.0f / 2048.0f) + LN_EPS);
#pragma unroll
        for (int k = 0; k < 8; ++k) { const int c = 32 * lo + 4 * k;
            const float4 w0 = *(const float4*)(lw + c), b0 = *(const float4*)(lb + c);
            float4 y0;
            y0.x = acc[4 * k] * rstd * w0.x + b0.x; y0.y = acc[4 * k + 1] * rstd * w0.y + b0.y; y0.z = acc[4 * k + 2] * rstd * w0.z + b0.z; y0.w = acc[4 * k + 3] * rstd * w0.w + b0.w;
            *(float4*)(p.out + (size_t)tok * DM + c) = y0; }
    }
}

#define XB_TMO      128
#define XB_XCNT(j)  (256  + 64 * (j))
#define XB_XSUB(j)  (1280 + 64 * (j))
#define XB_XGEN(j)  (2304 + 64 * (j))
#define XB_TOP      3328
#define XB_TOPGEN   3392
#define XCD_BAR_WORDS 3456
#define XB_SPIN_CAP (1u << 18)

__device__ __forceinline__ unsigned xb_ld(unsigned* p)              { return __hip_atomic_load(p, __ATOMIC_RELAXED, __HIP_MEMORY_SCOPE_AGENT); }
__device__ __forceinline__ unsigned xb_add(unsigned* p, unsigned v) { return __hip_atomic_fetch_add(p, v, __ATOMIC_RELAXED, __HIP_MEMORY_SCOPE_AGENT); }
__device__ __forceinline__ unsigned xb_xcc_id() { return (unsigned)__builtin_amdgcn_s_getreg((3 << 11) | 20) & 0xFu; }
#define XB_SPIN(cond, bar) do { unsigned _sp = 0; while (cond) { __builtin_amdgcn_s_sleep(1); \
    if ((++_sp & 255u) == 0u) { if (xb_ld(&(bar)[XB_TMO])) break; if (_sp > XB_SPIN_CAP) { atomicAdd(&(bar)[XB_TMO], 1u); break; } } } } while (0)

struct XcdBarrier {
    unsigned* bar; unsigned x;
    volatile LAS unsigned* st;
};

__device__ __forceinline__ XcdBarrier xcd_barrier_post(unsigned* bar, volatile LAS unsigned* st) {
    XcdBarrier b; b.bar = bar; b.x = xb_xcc_id(); b.st = st;
    if (threadIdx.x == 0) (void)xb_add(&bar[XB_XCNT(b.x)], 1u);
    return b;
}
__device__ __forceinline__ void xcd_barrier_complete(unsigned* bar, unsigned x, unsigned& nloc, unsigned& nx) {
    const unsigned G = gridDim.x * gridDim.y * gridDim.z;
    unsigned sum, cnt, mine, sp = 0u;
    for (;;) {
        sum = 0u; cnt = 0u; mine = 0u;
#pragma unroll
        for (unsigned j = 0; j < 16; ++j) { const unsigned c = xb_ld(&bar[XB_XCNT(j)]); sum += c; cnt += (c > 0u) ? 1u : 0u; mine = (j == x) ? c : mine; }
        if (sum == G) break;
        __builtin_amdgcn_s_sleep(1);
        if ((++sp & 255u) == 0u) { if (xb_ld(&bar[XB_TMO])) break; if (sp > XB_SPIN_CAP) { atomicAdd(&bar[XB_TMO], 1u); break; } }
    }
    nloc = mine > 0u ? mine : 1u; nx = cnt > 0u ? cnt : 1u;
}

__device__ __forceinline__ void xcd_barrier(const XcdBarrier& b) {
    asm volatile("s_waitcnt vmcnt(0)" ::: "memory");
    __syncthreads();
    if (threadIdx.x == 0) {
        unsigned* bar = b.bar;
        __builtin_amdgcn_s_waitcnt(0);
        unsigned nloc = b.st[0], nx = b.st[1];
        if (nloc == 0u) { xcd_barrier_complete(bar, b.x, nloc, nx); b.st[0] = nloc; b.st[1] = nx; }
        const unsigned old = xb_add(&bar[XB_XSUB(b.x)], 1u);
        const unsigned gen = old / nloc;
        if (old + 1u == (gen + 1u) * nloc) {
            __builtin_amdgcn_fence(__ATOMIC_RELEASE, "agent");
            asm volatile("s_waitcnt vmcnt(0)" ::: "memory");
            const unsigned og = xb_add(&bar[XB_TOP], 1u);
            const unsigned tg = og / nx;
            if (og + 1u == (tg + 1u) * nx) xb_add(&bar[XB_TOPGEN], 1u);
            else XB_SPIN(xb_ld(&bar[XB_TOPGEN]) == tg, bar);
            __builtin_amdgcn_fence(__ATOMIC_ACQUIRE, "agent");
            xb_add(&bar[XB_XGEN(b.x)], 1u);
            asm volatile("s_waitcnt vmcnt(0)" ::: "memory");
        } else {
            XB_SPIN(xb_ld(&bar[XB_XGEN(b.x)]) == gen, bar);
            __builtin_amdgcn_fence(__ATOMIC_ACQUIRE, "agent");
            asm volatile("s_waitcnt vmcnt(0)" ::: "memory");
        }
    }
    __syncthreads();
}


__global__ void __launch_bounds__(512, 2) hybrid_fwd(Params p) {
    extern __shared__ __attribute__((aligned(16))) unsigned char lds[];
    volatile LAS unsigned* bst = (volatile LAS unsigned*)((LAS unsigned char*)lds + LDS_BYTES - 64);
    XcdBarrier xbar; xbar.bar = (unsigned*)(p.ws + OFF_CTL + 1024); xbar.x = 0; xbar.st = bst;
    if (p.coop) { if (threadIdx.x == 0) { bst[0] = 0u; bst[1] = 0u; } __syncthreads(); xbar = xcd_barrier_post((unsigned*)(p.ws + OFF_CTL + 1024), bst); }
#define GRID_SEAM(n) do { if ((n) == 1) cg::this_grid().sync(); else xcd_barrier(xbar); } while (0)
#define B16(off) ((bf16_t*)(p.ws + (off)))
#define F32(off) ((float*)(p.ws + (off)))
#ifndef REPEAT_MASK
#define REPEAT_MASK 0
#endif
#ifdef ONLY_PHASE
#define PH_COND(n) ((n) == ONLY_PHASE && p.ph_lo <= (n) && (n) < p.ph_hi)
#else
#define PH_COND(n) (p.ph_lo <= (n) && (n) < p.ph_hi)
#endif
#define PH_BEGIN(n) if (PH_COND(n)) { if ((n) > p.ph_lo && p.coop) GRID_SEAM(n); for (int rep = 0; rep < (((REPEAT_MASK >> (n)) & 1) ? 2 : 1); ++rep) { if (rep && p.coop) cg::this_grid().sync();
#define PH_END } }
    PH_BEGIN(0) {
#if !defined(P0SEL) || P0SEL == 0
            ph_prep_x(p, lds);
#endif
#if !defined(P0SEL) || P0SEL == 1
            ph_prep_w(p, lds);
#endif
#if !defined(P0SEL) || P0SEL == 2
            cvt_f32_fp8(p.mem, p.ws + OFF_MEMB, (size_t)1024 * DM / 16, XQ_SCALE);
#endif
        } PH_END
    PH_BEGIN(1) {
            pg8::EpiB16 E; E.O0 = B16(OFF_P1); E.ldc0 = P1_LD; E.O1 = B16(OFF_VT); E.ldc1 = T_TOK; E.scale = 1.0f / (XQ_SCALE * WQ_SCALE);
            pg8::run_gemm2<pg8::EpiB16, true>(lds, B16(OFF_XB), B16(OFF_WMAIN), T_TOK, P1_LD, B16(OFF_WV), B16(OFF_XB), 4096, T_TOK, E, DM / 2);
        } PH_END
    PH_BEGIN(2) ph_scans(p); ph_conv(p); PH_END
    PH_BEGIN(3) ph_mixers(p, lds, rep); PH_END
    PH_BEGIN(4) {
            { pg8::EpiB16 E; E.O0 = B16(OFF_KC); E.ldc0 = DM; E.O1 = B16(OFF_VCT); E.ldc1 = 1024; E.scale = 1.0f;
              pg8::run_gemm2<pg8::EpiB16, true>(lds, B16(OFF_MEMB), B16(OFF_WXKV), 1024, 2048, B16(OFF_WXKV) + (size_t)2048 * DM / 2, B16(OFF_MEMB), 2048, 1024, E, DM / 2, 15); }
            if (gridDim.x > 64) { if (blockIdx.x >= 64) ph_mlnorm(p, blockIdx.x - 64, gridDim.x - 64); } else ph_mlnorm(p, blockIdx.x, gridDim.x);
        } PH_END
    PH_BEGIN(5) {
            pg8::EpiBr E; E.T1 = B16(OFF_T1); E.gate0 = B16(OFF_P1) + 8192; E.gate1 = B16(OFF_P1) + 10240; E.ldg = P1_LD; E.O = B16(OFF_MRG);
            pg8::run_gemm2<pg8::EpiBr, true>(lds, B16(OFF_HB), B16(OFF_WSQ), T_TOK, DM, B16(OFF_YB), B16(OFF_WSQ + 8 * MiB), T_TOK, DM, E, DM / 2);
        } PH_END
    PH_BEGIN(6) { pg8::EpiResB<false> E; E.C = B16(OFF_PRE); E.R = p.x; E.alpha = DN_ALPHA; pg8::run_gemm2<pg8::EpiResB<false>, true>(lds, B16(OFF_MRG), B16(OFF_WSQ + 16 * MiB), T_TOK, DM, nullptr, nullptr, 0, 0, E, DM / 2, 16); } PH_END
    PH_BEGIN(7) {
            ph_ln_rows(B16(OFF_PRE), p.ln_w, p.ln_b, B16(OFF_X1B), p.ws + OFF_X1Q);
            __syncthreads(); cvt_f32_fp6(p.peer_u, p.ws + OFF_UB, (size_t)16384 * DM / 32, U6_SCALE, lds); cvt_f32_fp6(p.peer_v, p.ws + OFF_VB, (size_t)16384 * DM / 32, V6_SCALE, lds);
        } PH_END
    PH_BEGIN(8) { pg8::EpiB16 E; E.O0 = B16(OFF_QX); E.ldc0 = DM; E.O1 = nullptr; E.ldc1 = 0; E.scale = 1.0f; pg8::run_gemm2<pg8::EpiB16, true>(lds, B16(OFF_X1Q), B16(OFF_WSQ + 24 * MiB), T_TOK, DM, nullptr, nullptr, 0, 0, E, DM / 2); } PH_END
    PH_BEGIN(9) { for (int it = blockIdx.x; it < 256; it += gridDim.x) xattn_item(p, lds, it >> 6, (it >> 4) & 3, it & 15); } PH_END
    PH_BEGIN(10) { pg8::EpiResB<true> E; E.C = B16(OFF_PRE); E.R = B16(OFF_X1B); E.alpha = DN_ALPHA; pg8::run_gemm2<pg8::EpiResB<true>, true>(lds, B16(OFF_OB), B16(OFF_WSQ + 32 * MiB), T_TOK, DM, nullptr, nullptr, 0, 0, E, DM / 2, 17); } PH_END
    PH_BEGIN(11) ph_ln_rows(B16(OFF_PRE), p.ln_w + DM, p.ln_b + DM, B16(OFF_X2B), nullptr); PH_END
    PH_BEGIN(12) { pg8::EpiRes E; E.C = F32(OFF_QP); E.R = nullptr; E.alpha = 0.f; pg8::run_gemm2(lds, B16(OFF_X2B), B16(OFF_WSQ + 40 * MiB), T_TOK, DM, nullptr, nullptr, 0, 0, E); } PH_END
    PH_BEGIN(13) ph_peer_score(p, lds); PH_END
    PH_BEGIN(14) ph_peer_gather6(p, lds); PH_END
}

extern "C" void kernel_launch(void* const* d_in, const int* in_sizes, int n_in, void* d_out, int out_size, void* d_ws, size_t ws_size, hipStream_t stream) {
    static int grid = 0;
    if (grid == 0) {
        if (ws_size < WS_END) { fprintf(stderr, "kernel_launch: workspace too small (%zu < %zu)\n", ws_size, (size_t)WS_END); grid = -1; return; }
        int dev = 0, cus = 0, per_cu = 0;
        hipGetDevice(&dev); hipDeviceGetAttribute(&cus, hipDeviceAttributeMultiprocessorCount, dev);
        hipFuncSetAttribute((const void*)hybrid_fwd, hipFuncAttributeMaxDynamicSharedMemorySize, LDS_BYTES);
        hipOccupancyMaxActiveBlocksPerMultiprocessor(&per_cu, (const void*)hybrid_fwd, 512, LDS_BYTES);
        if (per_cu < 1) per_cu = 1;
        (void)hipGetLastError();
        grid = cus * per_cu;
    }
    if (grid < 0) return;
    hipMemsetAsync((char*)d_ws + OFF_CTL, 0, 32768, stream);
    Params p{};
    p.x = (const float*)d_in[0]; p.mem = (const float*)d_in[1]; p.w_in = (const float*)d_in[2]; p.conv_w = (const float*)d_in[3]; p.conv_b = (const float*)d_in[4];
    p.gate_b = (const float*)d_in[5]; p.norm_w = (const float*)d_in[6]; p.fox_f_b = (const float*)d_in[7];
    p.w_sq[0] = (const float*)d_in[8]; p.w_sq[1] = (const float*)d_in[9]; p.w_sq[2] = (const float*)d_in[10]; p.w_sq[3] = (const float*)d_in[11];
    p.w_xkv = (const float*)d_in[12]; p.w_sq[4] = (const float*)d_in[13]; p.w_sq[5] = (const float*)d_in[14];
    p.sub_keys = (const float*)d_in[15]; p.peer_u = (const float*)d_in[16]; p.peer_v = (const float*)d_in[17]; p.ln_w = (const float*)d_in[18]; p.ln_b = (const float*)d_in[19];
    p.out = (float*)d_out; p.ws = (unsigned char*)d_ws;
#ifndef ONE_LAUNCH
#define ONE_LAUNCH 1
#endif
    if (ONE_LAUNCH) {
        p.ph_lo = 0; p.ph_hi = NPHASE + 1; p.coop = 1;
        void* args[] = {&p};
        hipError_t e = hipLaunchCooperativeKernel((const void*)hybrid_fwd, dim3(grid), dim3(512), args, LDS_BYTES, stream);
        if (e != hipSuccess) fprintf(stderr, "cooperative launch failed: %s (grid %d)\n", hipGetErrorString(e), grid);
    } else {
        for (int ph = 0; ph <= NPHASE; ++ph) { p.ph_lo = ph; p.ph_hi = ph + 1; p.coop = 0;
            hipLaunchKernelGGL(hybrid_fwd, dim3(grid), dim3(512), LDS_BYTES, stream, p); }
    }
}
```

```cpp
#include <hip/hip_runtime.h>
#include <hip/hip_cooperative_groups.h>
#include <cstdio>
namespace cg = cooperative_groups;

#define LAS __attribute__((address_space(3)))
typedef unsigned short bf16_t;
typedef short bf16x8 __attribute__((ext_vector_type(8)));
typedef float f32x4 __attribute__((ext_vector_type(4)));
typedef float f32x2 __attribute__((ext_vector_type(2)));
typedef unsigned u32x4 __attribute__((ext_vector_type(4)));
typedef unsigned u32x2 __attribute__((ext_vector_type(2)));

constexpr int T_TOK = 8192, DM = 2048, SEQ = 2048, W_IN_LD = 16408;
constexpr int P1_LD = 12288;
constexpr float DN_ALPHA = 1.189207115002721f;
constexpr float LN_EPS = 1e-5f;
constexpr float MQ_SCALE = 64.0f, OQ_SCALE = 128.0f;
constexpr float XQ_SCALE = 32.0f, WQ_SCALE = 1024.0f;
constexpr size_t MiB = (size_t)1 << 20;
constexpr size_t OFF_P1 = 0, OFF_VT = 192 * MiB, OFF_UB = 0, OFF_VB = 64 * MiB, OFF_PRE = 128 * MiB, OFF_X1F = 192 * MiB, OFF_QP = 192 * MiB;
constexpr size_t OFF_XB = 256 * MiB, OFF_HPRE = 256 * MiB, OFF_X1B = 256 * MiB, OFF_X2B = 256 * MiB;
constexpr size_t OFF_WMAIN = 288 * MiB, OFF_YB = 288 * MiB, OFF_QX = 288 * MiB, OFF_HB = 320 * MiB, OFF_OB = 320 * MiB, OFF_WV = 336 * MiB;
constexpr size_t OFF_WSQ = 352 * MiB, OFF_WXKV = 400 * MiB, OFF_MEMB = 416 * MiB, OFF_T1 = 424 * MiB, OFF_X2F = 424 * MiB;
constexpr size_t OFF_MRG = 488 * MiB, OFF_QKC = 488 * MiB, OFF_IDX = 520 * MiB, OFF_G = 524 * MiB, OFF_KC = 528 * MiB, OFF_VCT = 532 * MiB;
constexpr size_t OFF_GATES = 536 * MiB, OFF_FOXF = 537 * MiB, OFF_MLB = 538 * MiB, OFF_MLMP = 538 * MiB + 256 * 1024, OFF_MLFC = 538 * MiB + 512 * 1024;
constexpr size_t OFF_CTL = 539 * MiB, WS_END = 540 * MiB;
constexpr size_t OFF_X1Q = OFF_T1;
constexpr int LDS_BYTES = 153 * 1024;
constexpr int NPHASE = 14;

struct Params {
    const float *x, *mem, *w_in, *conv_w, *conv_b, *gate_b, *norm_w, *fox_f_b;
    const float *w_sq[6];
    const float *w_xkv, *sub_keys, *peer_u, *peer_v, *ln_w, *ln_b;
    float* out; unsigned char* ws;
    int ph_lo, ph_hi, coop, pad;
};

__device__ __forceinline__ unsigned cvt_pk_bf16(float lo, float hi) { unsigned r; asm volatile("v_cvt_pk_bf16_f32 %0, %1, %2" : "=v"(r) : "v"(lo), "v"(hi)); return r; }
__device__ __forceinline__ float bflo(unsigned w) { return __uint_as_float(w << 16); }
__device__ __forceinline__ float bfhi(unsigned w) { return __uint_as_float(w & 0xffff0000u); }
__device__ __forceinline__ float wsum(float v) {
    v += __int_as_float(__builtin_amdgcn_update_dpp(0, __float_as_int(v), 0x111, 0xf, 0xf, true));
    v += __int_as_float(__builtin_amdgcn_update_dpp(0, __float_as_int(v), 0x112, 0xf, 0xf, true));
    v += __int_as_float(__builtin_amdgcn_update_dpp(0, __float_as_int(v), 0x114, 0xf, 0xf, true));
    v += __int_as_float(__builtin_amdgcn_update_dpp(0, __float_as_int(v), 0x118, 0xf, 0xf, true));
    v += __int_as_float(__builtin_amdgcn_update_dpp(0, __float_as_int(v), 0x142, 0xa, 0xf, false));
    v += __int_as_float(__builtin_amdgcn_update_dpp(0, __float_as_int(v), 0x143, 0xc, 0xf, false));
    return __int_as_float(__builtin_amdgcn_readlane(__float_as_int(v), 63)); }
__device__ __forceinline__ unsigned wmaxu(unsigned v) {
#pragma unroll
    for (int o = 32; o > 0; o >>= 1) { unsigned t = (unsigned)__shfl_xor((int)v, o); v = t > v ? t : v; }
    return v; }
__device__ __forceinline__ float clamp8(float x) { return fminf(fmaxf(x, -440.f), 440.f); }
__device__ __forceinline__ float sigmoidf_(float x) { return 1.0f / (1.0f + __expf(-x)); }
__device__ __forceinline__ float logsigf_(float z) { return fminf(z, 0.0f) - log1pf(expf(-fabsf(z))); }

namespace pg8 {
constexpr int BM = 256, BK = 64, HALF = 128, HTB = HALF * BK * 2, STAGE_BYTES = 8 * HTB, NXCD = 8, WGM = 8;
__device__ __forceinline__ int lds_byte(int r, int c) { const int st = (r >> 4) * 2 + (c >> 5), rr = r & 15, cc = c & 31, ob = rr * 64 + cc * 2; return st * 1024 + (ob ^ (((ob >> 9) & 1) << 5)); }
__device__ __forceinline__ void stage_rc(int b, int& R, int& C) { const int st = b / 1024, sb = b % 1024, swz = sb ^ (((sb >> 9) & 1) << 5); R = (st >> 1) * 16 + swz / 64; C = (st & 1) * 32 + (swz % 64) / 2; }
__device__ __forceinline__ int perm32(int rho) { const int n = rho >> 4, i = rho & 15; return 8 * (i >> 2) + 4 * n + (i & 3); }
struct Unit { int pm, pn, which; };
struct Gemm { const bf16_t* A[2]; const bf16_t* Bt[2]; int M[2], N[2]; int K, lda, ldb; int sca, scb; };
struct StaticOrder {
    int nM[2], nN[2], nwg[2], G, c;
    __device__ void init(const Gemm& g, int G_, int c_) { for (int i = 0; i < 2; ++i) { nM[i] = g.M[i] / BM; nN[i] = g.N[i] / BM; nwg[i] = nM[i] * nN[i]; } G = G_; c = c_; }
    __device__ bool next(int i, Unit& u) const {
        long L = (long)i * G + c; int w = 0;
        if (L >= nwg[0]) { L -= nwg[0]; w = 1; if (L >= nwg[1]) return false; }
        const int nwg_ = w ? nwg[1] : nwg[0], nM_ = w ? nM[1] : nM[0], nN_ = w ? nN[1] : nN[0];
        int wgid = (int)L; { const int q = nwg_ / NXCD, r = nwg_ % NXCD, xcd = wgid % NXCD, off = wgid / NXCD; wgid = (xcd < r ? xcd * (q + 1) : r * (q + 1) + (xcd - r) * q) + off; }
        const int nig = WGM * nN_, gid = wgid / nig, fm = gid * WGM, gsz = (nM_ - fm) < WGM ? (nM_ - fm) : WGM;
        u.pm = fm + ((wgid % nig) % gsz); u.pn = (wgid % nig) / gsz; u.which = w; return true;
    }
};
struct EpiB16 {
    static constexpr bool PERM = true;
    bf16_t* O0; bf16_t* O1; int ldc0, ldc1; float scale;
    __device__ __forceinline__ void operator()(const f32x4 (&acc)[2][2][4][2], const Unit& u, int wr, int wc, int fr, int fq) const {
        const int row0 = u.pm * BM + wr * 64 + fr, col0 = u.pn * BM + wc * 32 + 8 * fq;
        bf16_t* const O = u.which ? O1 : O0; const int ldc = u.which ? ldc1 : ldc0;
#pragma unroll
        for (int ai = 0; ai < 2; ++ai)
#pragma unroll
            for (int m = 0; m < 4; ++m) { bf16_t* rowp = O + (size_t)(row0 + ai * HALF + m * 16) * ldc + col0;
#pragma unroll
                for (int bj = 0; bj < 2; ++bj) { const f32x4 v0 = acc[ai][bj][m][0], v1 = acc[ai][bj][m][1];
                    u32x4 w; w.x = cvt_pk_bf16(v0[0], v0[1]); w.y = cvt_pk_bf16(v0[2], v0[3]); w.z = cvt_pk_bf16(v1[0], v1[1]); w.w = cvt_pk_bf16(v1[2], v1[3]);
                    *(u32x4*)(rowp + bj * HALF) = w; } }
    }
};
struct EpiBr {
    static constexpr bool PERM = true;
    bf16_t* T1; const bf16_t* gate0; const bf16_t* gate1; int ldg; bf16_t* O;
    __device__ __forceinline__ void operator()(const f32x4 (&acc)[2][2][4][2], const Unit& u, int wr, int wc, int fr, int fq) const {
        const int row0 = u.pm * BM + wr * 64 + fr, col0 = u.pn * BM + wc * 32 + 8 * fq;
        const bf16_t* const gate = u.which ? gate1 : gate0;
#pragma unroll
        for (int ai = 0; ai < 2; ++ai)
#pragma unroll
            for (int m = 0; m < 4; ++m) { const size_t r = (size_t)(row0 + ai * HALF + m * 16);
#pragma unroll
                for (int bj = 0; bj < 2; ++bj) { const f32x4 v0 = acc[ai][bj][m][0], v1 = acc[ai][bj][m][1];
                    const u32x4 gw = *(const u32x4*)(gate + r * ldg + col0 + bj * HALF);
                    bf16_t* tp = T1 + r * DM + col0 + bj * HALF;
                    f32x4 o0, o1;
                    o0[0] = sigmoidf_(bflo(gw.x)) * v0[0]; o0[1] = sigmoidf_(bfhi(gw.x)) * v0[1]; o0[2] = sigmoidf_(bflo(gw.y)) * v0[2]; o0[3] = sigmoidf_(bfhi(gw.y)) * v0[3];
                    o1[0] = sigmoidf_(bflo(gw.z)) * v1[0]; o1[1] = sigmoidf_(bfhi(gw.z)) * v1[1]; o1[2] = sigmoidf_(bflo(gw.w)) * v1[2]; o1[3] = sigmoidf_(bfhi(gw.w)) * v1[3];
                    if (u.which) { const u32x4 t = *(const u32x4*)tp;
                        o0[0] += bflo(t.x); o0[1] += bfhi(t.x); o0[2] += bflo(t.y); o0[3] += bfhi(t.y); o1[0] += bflo(t.z); o1[1] += bfhi(t.z); o1[2] += bflo(t.w); o1[3] += bfhi(t.w); }
                    if (u.which) {
                        int a = __builtin_amdgcn_cvt_pk_fp8_f32(clamp8(o0[0] * MQ_SCALE), clamp8(o0[1] * MQ_SCALE), 0, false); a = __builtin_amdgcn_cvt_pk_fp8_f32(clamp8(o0[2] * MQ_SCALE), clamp8(o0[3] * MQ_SCALE), a, true);
                        int b = __builtin_amdgcn_cvt_pk_fp8_f32(clamp8(o1[0] * MQ_SCALE), clamp8(o1[1] * MQ_SCALE), 0, false); b = __builtin_amdgcn_cvt_pk_fp8_f32(clamp8(o1[2] * MQ_SCALE), clamp8(o1[3] * MQ_SCALE), b, true);
                        u32x2 q8; q8.x = (unsigned)a; q8.y = (unsigned)b; *(u32x2*)((unsigned char*)O + r * DM + col0 + bj * HALF) = q8;
                    } else { u32x4 w; w.x = cvt_pk_bf16(o0[0], o0[1]); w.y = cvt_pk_bf16(o0[2], o0[3]); w.z = cvt_pk_bf16(o1[0], o1[1]); w.w = cvt_pk_bf16(o1[2], o1[3]); *(u32x4*)tp = w; } } }
    }
};
template <bool RB16> struct EpiResB {
    static constexpr bool PERM = true;
    bf16_t* C; const void* R; float alpha;
    __device__ __forceinline__ void operator()(const f32x4 (&acc)[2][2][4][2], const Unit& u, int wr, int wc, int fr, int fq) const {
        const int row0 = u.pm * BM + wr * 64 + fr, col0 = u.pn * BM + wc * 32 + 8 * fq;
#pragma unroll
        for (int ai = 0; ai < 2; ++ai)
#pragma unroll
            for (int m = 0; m < 4; ++m) { const size_t ro = (size_t)(row0 + ai * HALF + m * 16) * DM + col0;
#pragma unroll
                for (int bj = 0; bj < 2; ++bj) { f32x4 v0 = acc[ai][bj][m][0], v1 = acc[ai][bj][m][1];
                    if (RB16) { const u32x4 t = *(const u32x4*)((const bf16_t*)R + ro + bj * HALF);
                        v0[0] += alpha * bflo(t.x); v0[1] += alpha * bfhi(t.x); v0[2] += alpha * bflo(t.y); v0[3] += alpha * bfhi(t.y); v1[0] += alpha * bflo(t.z); v1[1] += alpha * bfhi(t.z); v1[2] += alpha * bflo(t.w); v1[3] += alpha * bfhi(t.w); }
                    else { const f32x4 r0 = *(const f32x4*)((const float*)R + ro + bj * HALF), r1 = *(const f32x4*)((const float*)R + ro + bj * HALF + 4); v0 = v0 + r0 * alpha; v1 = v1 + r1 * alpha; }
                    u32x4 w; w.x = cvt_pk_bf16(v0[0], v0[1]); w.y = cvt_pk_bf16(v0[2], v0[3]); w.z = cvt_pk_bf16(v1[0], v1[1]); w.w = cvt_pk_bf16(v1[2], v1[3]);
                    *(u32x4*)(C + ro + bj * HALF) = w; } }
    }
};
struct EpiRes {
    static constexpr bool PERM = false;
    float* C; const float* R; float alpha;
    __device__ __forceinline__ void operator()(const f32x4 (&acc)[2][2][4][2], const Unit& u, int wr, int wc, int fr, int fq) const {
        const int row0 = u.pm * BM + wr * 64 + fr, col0 = u.pn * BM + wc * 32 + 4 * fq;
#pragma unroll
        for (int ai = 0; ai < 2; ++ai)
#pragma unroll
            for (int m = 0; m < 4; ++m) { const size_t ro = (size_t)(row0 + ai * HALF + m * 16) * DM + col0;
#pragma unroll
                for (int bj = 0; bj < 2; ++bj)
#pragma unroll
                    for (int n = 0; n < 2; ++n) { f32x4 v = acc[ai][bj][m][n];
                        if (R) { const f32x4 rv = *(const f32x4*)(R + ro + bj * HALF + n * 16); v = v + rv * alpha; }
                        *(f32x4*)(C + ro + bj * HALF + n * 16) = v; } }
    }
};

typedef int i32x8 __attribute__((ext_vector_type(8)));
typedef int i32x4 __attribute__((ext_vector_type(4)));
template <class Epi, bool FP8 = false>
__device__ __forceinline__ void gemm_phase(LAS unsigned char* lds, const Gemm g, const StaticOrder& S, const Epi& E) {
    const int tid = threadIdx.x, wid = __builtin_amdgcn_readfirstlane(tid >> 6), lane = tid & 63, wr = wid >> 2, wc = wid & 3, fr = lane & 15, fq = lane >> 4;
    const int K = g.K, nt = K / BK;
    unsigned voffA[2], voffB[2];
#pragma unroll
    for (int i = 0; i < 2; ++i) { int R, C; stage_rc(tid * 16 + i * 8192, R, C); const int Rb = Epi::PERM ? ((R & ~31) + perm32(R & 31)) : R;
        voffA[i] = (unsigned)(R * g.lda + C) * 2u; voffB[i] = (unsigned)(Rb * g.ldb + C) * 2u; }
    const size_t kstep = (size_t)(BK * 2);
    const size_t hstepA = (size_t)HALF * g.lda * 2, hstepB = (size_t)HALF * g.ldb * 2;
    const size_t tstepA = 2 * hstepA, tstepB = 2 * hstepB;
    const unsigned ldsw = (unsigned)wid * 1024u;
    const int aoff = lds_byte(wr * 64 + fr, fq * 8), boff = lds_byte(wc * 32 + fr, fq * 8);
#define PG8_SA(b, h) (((b) * 2 + (h)) * HTB)
#define PG8_SB(b, h) ((4 + (b) * 2 + (h)) * HTB)
#define PG8_STAGE(bufoff, gbase, voff) do { _Pragma("unroll") for (int _i = 0; _i < 2; ++_i) \
        __builtin_amdgcn_global_load_lds((const unsigned*)((const char*)(gbase) + (voff)[_i]), (LAS unsigned*)(lds + (bufoff) + ldsw + _i * 8192), 16, 0, 0); } while (0)
#define PG8_RD4(off) (*(const LAS i32x4*)(lds + (off)))
#define PG8_LDA(dst, b, h) do { if (FP8) { _Pragma("unroll") for (int m = 0; m < 4; ++m) dst##8[m] = __builtin_shufflevector(PG8_RD4(PG8_SA(b, h) + aoff + m * 2048), PG8_RD4(PG8_SA(b, h) + aoff + m * 2048 + 1024), 0, 1, 2, 3, 4, 5, 6, 7); } \
        else { _Pragma("unroll") for (int m = 0; m < 4; ++m) _Pragma("unroll") for (int k = 0; k < 2; ++k) dst[m][k] = *(const LAS bf16x8*)(lds + PG8_SA(b, h) + aoff + m * 2048 + k * 1024); } } while (0)
#define PG8_LDB(dst, b, h) do { if (FP8) { _Pragma("unroll") for (int n = 0; n < 2; ++n) dst##8[n] = __builtin_shufflevector(PG8_RD4(PG8_SB(b, h) + boff + n * 2048), PG8_RD4(PG8_SB(b, h) + boff + n * 2048 + 1024), 0, 1, 2, 3, 4, 5, 6, 7); } \
        else { _Pragma("unroll") for (int n = 0; n < 2; ++n) _Pragma("unroll") for (int k = 0; k < 2; ++k) dst[n][k] = *(const LAS bf16x8*)(lds + PG8_SB(b, h) + boff + n * 2048 + k * 1024); } } while (0)
#define PG8_MMA(ai, bj, At, Bt) do { __builtin_amdgcn_s_setprio(1); \
        if (FP8) { _Pragma("unroll") for (int m = 0; m < 4; ++m) _Pragma("unroll") for (int n = 0; n < 2; ++n) \
            asm volatile("v_mfma_scale_f32_16x16x128_f8f6f4 %0, %1, %2, %0, %3, %4 op_sel_hi:[0,0,0]" : "+v"(acc[ai][bj][m][n]) : "v"(Bt##8[n]), "v"(At##8[m]), "v"(sc_b8), "v"(sc_a8)); } \
        else { _Pragma("unroll") for (int m = 0; m < 4; ++m) _Pragma("unroll") for (int n = 0; n < 2; ++n) _Pragma("unroll") for (int k = 0; k < 2; ++k) \
            acc[ai][bj][m][n] = __builtin_amdgcn_mfma_f32_16x16x32_bf16(Bt[n][k], At[m][k], acc[ai][bj][m][n], 0, 0, 0); } \
        __builtin_amdgcn_s_setprio(0); } while (0)
#define PG8_WAIT_V(n) asm volatile("s_waitcnt vmcnt(" #n ")" ::: "memory")
#define PG8_WAIT_L(n) asm volatile("s_waitcnt lgkmcnt(" #n ")" ::: "memory")
#define PG8_BAR __builtin_amdgcn_s_barrier()
#define PG8_SCHED __builtin_amdgcn_sched_barrier(0)
#define PG8_FSCHED do { if (FP8) __builtin_amdgcn_sched_barrier(0); } while (0)
    Unit cur, nxt; int ui = 0;
    if (!S.next(0, cur)) return;
    f32x4 acc[2][2][4][2];
#pragma unroll
    for (int a = 0; a < 2; ++a)
#pragma unroll
        for (int b = 0; b < 2; ++b)
#pragma unroll
            for (int m = 0; m < 4; ++m)
#pragma unroll
                for (int n = 0; n < 2; ++n) acc[a][b][m][n] = (f32x4){0.f, 0.f, 0.f, 0.f};
    bf16x8 At[4][2], B0[2][2], B1[2][2];
    i32x8 At8[4], B08[2], B18[2];
    const int sc_a8 = g.sca, sc_b8 = g.scb;
    const char* cA = (const char*)(cur.which ? g.A[1] : g.A[0]) + (size_t)cur.pm * tstepA; const char* cB = (const char*)(cur.which ? g.Bt[1] : g.Bt[0]) + (size_t)cur.pn * tstepB;
    PG8_STAGE(PG8_SB(0, 0), cB, voffB); PG8_STAGE(PG8_SA(0, 0), cA, voffA); PG8_STAGE(PG8_SB(0, 1), cB + hstepB, voffB); PG8_STAGE(PG8_SA(0, 1), cA + hstepA, voffA);
    if (wr == 1) PG8_BAR;
    PG8_WAIT_V(4); PG8_BAR;
    PG8_STAGE(PG8_SB(1, 0), cB + kstep, voffB); PG8_STAGE(PG8_SA(1, 0), cA + kstep, voffA); PG8_STAGE(PG8_SB(1, 1), cB + hstepB + kstep, voffB);
    PG8_WAIT_V(6); PG8_BAR;
    for (;;) {
        const bool has_next = S.next(ui + 1, nxt);
        const char* nA = has_next ? (const char*)(nxt.which ? g.A[1] : g.A[0]) + (size_t)nxt.pm * tstepA : cA; const char* nB = has_next ? (const char*)(nxt.which ? g.Bt[1] : g.Bt[0]) + (size_t)nxt.pn * tstepB : cB;
        for (int t = 0; t < nt; t += 2) {
            const bool last = (t == nt - 2);
            const char* a1 = cA + (size_t)(t + 1) * kstep;
            const char* a2 = last ? nA : cA + (size_t)(t + 2) * kstep; const char* b2 = last ? nB : cB + (size_t)(t + 2) * kstep;
            const char* a3 = a2 + kstep; const char* b3 = b2 + kstep;
            PG8_FSCHED; PG8_LDB(B0, 0, 0); PG8_SCHED; PG8_LDA(At, 0, 0); PG8_STAGE(PG8_SA(1, 1), a1 + hstepA, voffA);
            PG8_WAIT_L(8); PG8_BAR; PG8_WAIT_L(0); PG8_MMA(0, 0, At, B0); PG8_BAR; PG8_SCHED;
            PG8_FSCHED; PG8_LDB(B1, 0, 1); PG8_STAGE(PG8_SB(0, 0), b2, voffB);
            PG8_BAR; PG8_WAIT_L(0); PG8_MMA(0, 1, At, B1); PG8_BAR;
            PG8_FSCHED; PG8_LDA(At, 0, 1); PG8_STAGE(PG8_SA(0, 0), a2, voffA);
            PG8_BAR; PG8_WAIT_L(0); PG8_MMA(1, 0, At, B0); PG8_BAR; PG8_SCHED;
            PG8_STAGE(PG8_SB(0, 1), b2 + hstepB, voffB);
            PG8_WAIT_V(6); PG8_BAR; PG8_MMA(1, 1, At, B1); PG8_BAR; PG8_FSCHED;
            PG8_FSCHED; PG8_LDB(B0, 1, 0); PG8_SCHED; PG8_LDA(At, 1, 0); PG8_STAGE(PG8_SA(0, 1), a2 + hstepA, voffA);
            PG8_WAIT_L(8); PG8_BAR; PG8_WAIT_L(0); PG8_MMA(0, 0, At, B0); PG8_BAR; PG8_SCHED;
            PG8_FSCHED; PG8_LDB(B1, 1, 1); PG8_STAGE(PG8_SB(1, 0), b3, voffB);
            PG8_BAR; PG8_WAIT_L(0); PG8_MMA(0, 1, At, B1); PG8_BAR;
            PG8_FSCHED; PG8_LDA(At, 1, 1); PG8_STAGE(PG8_SA(1, 0), a3, voffA);
            PG8_BAR; PG8_WAIT_L(0); PG8_MMA(1, 0, At, B0); PG8_BAR; PG8_SCHED;
            PG8_STAGE(PG8_SB(1, 1), b3 + hstepB, voffB);
            PG8_WAIT_V(6); PG8_BAR; PG8_MMA(1, 1, At, B1); PG8_BAR; PG8_FSCHED;
        }
        if (FP8) asm volatile("s_nop 15\n\ts_nop 15" ::: "memory");
        E(acc, cur, wr, wc, fr, fq);
        if (!has_next) break;
#pragma unroll
        for (int a = 0; a < 2; ++a)
#pragma unroll
            for (int b = 0; b < 2; ++b)
#pragma unroll
                for (int m = 0; m < 4; ++m)
#pragma unroll
                    for (int n = 0; n < 2; ++n) acc[a][b][m][n] = (f32x4){0.f, 0.f, 0.f, 0.f};
        cur = nxt; cA = nA; cB = nB; ++ui;
    }
    PG8_WAIT_V(0);
    if (wr == 0) PG8_BAR;
    PG8_BAR;
#undef PG8_SA
#undef PG8_SB
#undef PG8_STAGE
#undef PG8_LDA
#undef PG8_LDB
#undef PG8_MMA
#undef PG8_RD4
#undef PG8_WAIT_V
#undef PG8_WAIT_L
#undef PG8_BAR
#undef PG8_SCHED
#undef PG8_FSCHED
}
template <class Epi, bool FP8 = false>
__device__ __forceinline__ void run_gemm2(unsigned char* lds, const bf16_t* A0, const bf16_t* B0, int M0, int N0, const bf16_t* A1, const bf16_t* B1, int M1, int N1, const Epi& E, int K2 = DM, int eneg = 15) {
    Gemm g; g.A[0] = A0; g.Bt[0] = B0; g.M[0] = M0; g.N[0] = N0; g.A[1] = A1; g.Bt[1] = B1; g.M[1] = M1; g.N[1] = N1; g.K = K2; g.lda = K2; g.ldb = K2;
    { const int ea = 127 - eneg / 2, eb = 127 - (eneg - eneg / 2); g.sca = ea * 0x01010101; g.scb = eb * 0x01010101; }
    StaticOrder S; S.init(g, gridDim.x, blockIdx.x);
    gemm_phase<Epi, FP8>((LAS unsigned char*)lds, g, S, E);
    __syncthreads();
}
}

__device__ void ph_prep_x(const Params& p, unsigned char* lds_) {
    float* rowbuf = (float*)lds_;
    bf16_t* Xb = (bf16_t*)(p.ws + OFF_XB); float* GA = (float*)(p.ws + OFF_GATES);
    const int tid = threadIdx.x, wid = tid >> 6, lane = tid & 63;
    float wr[3][32]; float bias[3]; int colv[3];
#pragma unroll
    for (int c = 0; c < 3; ++c) {
        const int gc = 3 * wid + c; colv[c] = gc < 8 ? 6144 + gc : 12296 + (gc - 8);
        bias[c] = gc < 8 ? p.gate_b[gc] : p.fox_f_b[gc - 8];
    }
    {
        const float* rp = p.w_in + (size_t)(4 * lane) * W_IN_LD;
#pragma unroll
        for (int j = 0; j < 8; ++j) {
#pragma unroll
            for (int i = 0; i < 4; ++i) {
                asm volatile("" : "+v"(rp));
                wr[0][j * 4 + i] = rp[colv[0]]; wr[1][j * 4 + i] = rp[colv[1]]; wr[2][j * 4 + i] = rp[colv[2]];
                rp += (i == 3) ? (size_t)253 * W_IN_LD : (size_t)W_IN_LD;
            }
        }
    }
    int it = 0;
    for (int tg = blockIdx.x; tg < T_TOK / 4; tg += gridDim.x, ++it) {
        float* buf = rowbuf + (it & 1) * 8192;
        float4 v[4];
#pragma unroll
        for (int c = 0; c < 4; ++c) v[c] = *(const float4*)(p.x + (size_t)(4 * tg + c) * DM + 4 * tid);
#pragma unroll
        for (int c = 0; c < 4; ++c) { int w8 = __builtin_amdgcn_cvt_pk_fp8_f32(clamp8(v[c].x * XQ_SCALE), clamp8(v[c].y * XQ_SCALE), 0, false); w8 = __builtin_amdgcn_cvt_pk_fp8_f32(clamp8(v[c].z * XQ_SCALE), clamp8(v[c].w * XQ_SCALE), w8, true);
            *(int*)((unsigned char*)Xb + (size_t)(4 * tg + c) * DM + 4 * tid) = w8; *(float4*)(buf + c * 2048 + 4 * tid) = v[c]; }
        __syncthreads();
#pragma unroll
        for (int c = 0; c < 4; ++c) {
            f32x2 p0 = (f32x2){0.f, 0.f}, p1 = (f32x2){0.f, 0.f}, p2 = (f32x2){0.f, 0.f};
#pragma unroll
            for (int j = 0; j < 8; ++j) {
                const float4 xv = *(const float4*)(buf + c * 2048 + 4 * lane + 256 * j);
                const f32x2 xlo = (f32x2){xv.x, xv.y}, xhi = (f32x2){xv.z, xv.w};
                p0 = __builtin_elementwise_fma(xlo, (f32x2){wr[0][4 * j], wr[0][4 * j + 1]}, p0); p0 = __builtin_elementwise_fma(xhi, (f32x2){wr[0][4 * j + 2], wr[0][4 * j + 3]}, p0);
                p1 = __builtin_elementwise_fma(xlo, (f32x2){wr[1][4 * j], wr[1][4 * j + 1]}, p1); p1 = __builtin_elementwise_fma(xhi, (f32x2){wr[1][4 * j + 2], wr[1][4 * j + 3]}, p1);
                p2 = __builtin_elementwise_fma(xlo, (f32x2){wr[2][4 * j], wr[2][4 * j + 1]}, p2); p2 = __builtin_elementwise_fma(xhi, (f32x2){wr[2][4 * j + 2], wr[2][4 * j + 3]}, p2);
            }
            float a0 = wsum(p0.x + p0.y), a1 = wsum(p1.x + p1.y), a2 = wsum(p2.x + p2.y);
            if (lane == 0) { float* gp = GA + (size_t)(4 * tg + c) * 24 + 3 * wid; gp[0] = a0 + bias[0]; gp[1] = a1 + bias[1]; gp[2] = a2 + bias[2]; }
        }
    }
    __syncthreads();
}

__device__ void ph_prep_w(const Params& p, unsigned char* lds_) {
    bf16_t* tT = (bf16_t*)lds_;
    const int tid = threadIdx.x;
#define PW_DECODE(gt_) do { const int gt = (gt_); isf8 = gt < 2048; \
        if (gt < 2048) { src = p.w_in; ld = W_IN_LD; \
            if (gt < 256) { col0 = 0; dbase = p.ws + OFF_WMAIN; drow = 0; lt = gt; } \
            else if (gt < 512) { col0 = 2048; dbase = p.ws + OFF_WV; drow = 0; lt = gt - 256; } \
            else if (gt < 768) { col0 = 4096; dbase = p.ws + OFF_WMAIN; drow = 2048; lt = gt - 512; } \
            else if (gt < 1280) { col0 = 6152; dbase = p.ws + OFF_WMAIN; drow = 4096; lt = gt - 768; } \
            else if (gt < 1536) { col0 = 10248; dbase = p.ws + OFF_WV; drow = 2048; lt = gt - 1280; } \
            else { col0 = 12312; dbase = p.ws + OFF_WMAIN; drow = 8192; lt = gt - 1536; } \
        } else if (gt < 3584) { const int j = (gt - 2048) >> 8; lt = (gt - 2048) & 255; ld = DM; col0 = 0; drow = 0; isf8 = (j != 5); \
            src = j == 0 ? p.w_sq[0] : j == 1 ? p.w_sq[1] : j == 2 ? p.w_sq[2] : j == 3 ? p.w_sq[3] : j == 4 ? p.w_sq[4] : p.w_sq[5]; \
            dbase = p.ws + OFF_WSQ + (size_t)j * 8 * MiB; \
        } else { src = p.w_xkv; ld = 4096; col0 = 0; drow = 0; lt = gt - 3584; dbase = p.ws + OFF_WXKV; isf8 = true; } } while (0)
#define PW_LOAD() do { if (isf8) { const int k0 = (lt & 15) * 128, n0 = (lt >> 4) * 128; _Pragma("unroll") for (int i = 0; i < 8; ++i) { const int q = tid + 512 * i, krow = q >> 5, c4 = q & 31; \
            v[i] = *(const float4*)(src + (size_t)(k0 + krow) * ld + col0 + n0 + 4 * c4); } } \
        else { const int k0 = (lt & 31) * 64, n0 = (lt >> 5) * 256; _Pragma("unroll") for (int i = 0; i < 8; ++i) { const int q = tid + 512 * i, krow = q >> 6, c4 = q & 63; \
            v[i] = *(const float4*)(src + (size_t)(k0 + krow) * ld + col0 + n0 + 4 * c4); } } } while (0)
    const float* src; unsigned char* dbase; int ld, col0, lt, drow; bool isf8;
    unsigned char* tT8 = lds_;
    float4 v[8];
    if ((int)blockIdx.x < 4096) { PW_DECODE(blockIdx.x); PW_LOAD(); }
    for (int gt0 = blockIdx.x; gt0 < 4096; gt0 += gridDim.x) {
        unsigned char* const dcur = dbase; const bool f8 = isf8; const int k0 = f8 ? (lt & 15) * 128 : (lt & 31) * 64, n0 = f8 ? (lt >> 4) * 128 : (lt >> 5) * 256, drc = drow;
        if (f8) {
#pragma unroll
            for (int i = 0; i < 8; ++i) { const int q = tid + 512 * i, krow = q >> 5, c4 = q & 31;
                const int a = __builtin_amdgcn_cvt_pk_fp8_f32(clamp8(v[i].x * WQ_SCALE), clamp8(v[i].y * WQ_SCALE), 0, false), b = __builtin_amdgcn_cvt_pk_fp8_f32(clamp8(v[i].z * WQ_SCALE), clamp8(v[i].w * WQ_SCALE), 0, false);
                tT8[(4 * c4 + 0) * 132 + krow] = (unsigned char)(a & 0xff); tT8[(4 * c4 + 1) * 132 + krow] = (unsigned char)((a >> 8) & 0xff);
                tT8[(4 * c4 + 2) * 132 + krow] = (unsigned char)(b & 0xff); tT8[(4 * c4 + 3) * 132 + krow] = (unsigned char)((b >> 8) & 0xff); }
        } else {
#pragma unroll
            for (int i = 0; i < 8; ++i) { const int q = tid + 512 * i, krow = q >> 6, c4 = q & 63;
                const unsigned a = cvt_pk_bf16(v[i].x, v[i].y), b = cvt_pk_bf16(v[i].z, v[i].w);
                tT[(4 * c4 + 0) * 66 + krow] = (bf16_t)(a & 0xffffu); tT[(4 * c4 + 1) * 66 + krow] = (bf16_t)(a >> 16);
                tT[(4 * c4 + 2) * 66 + krow] = (bf16_t)(b & 0xffffu); tT[(4 * c4 + 3) * 66 + krow] = (bf16_t)(b >> 16); }
        }
        __syncthreads();
        if (gt0 + (int)gridDim.x < 4096) { PW_DECODE(gt0 + (int)gridDim.x); PW_LOAD(); }
        if (f8) {
#pragma unroll
            for (int i = 0; i < 2; ++i) { const int q = tid + 512 * i, n = q >> 3, kg = q & 7; const unsigned* rp = (const unsigned*)(tT8 + n * 132 + kg * 16);
                u32x4 w; w.x = rp[0]; w.y = rp[1]; w.z = rp[2]; w.w = rp[3];
                *(u32x4*)(dcur + (size_t)(drc + n0 + n) * DM + k0 + kg * 16) = w; }
        } else {
#pragma unroll
            for (int i = 0; i < 4; ++i) { const int q = tid + 512 * i, n = q >> 3, kg = q & 7; const unsigned* rp = (const unsigned*)(tT + n * 66 + kg * 8);
                u32x4 w; w.x = rp[0]; w.y = rp[1]; w.z = rp[2]; w.w = rp[3];
                *(u32x4*)((bf16_t*)dcur + (size_t)(drc + n0 + n) * DM + k0 + kg * 8) = w; }
        }
        __syncthreads();
    }
#undef PW_DECODE
#undef PW_LOAD
}

__device__ void cvt_f32_bf16(const float* src, bf16_t* dst, size_t n8) {
    for (size_t i = (size_t)blockIdx.x * blockDim.x + threadIdx.x; i < n8; i += (size_t)gridDim.x * blockDim.x) {
        const float4 a = *(const float4*)(src + i * 8), b = *(const float4*)(src + i * 8 + 4);
        u32x4 w; w.x = cvt_pk_bf16(a.x, a.y); w.y = cvt_pk_bf16(a.z, a.w); w.z = cvt_pk_bf16(b.x, b.y); w.w = cvt_pk_bf16(b.z, b.w);
        *(u32x4*)(dst + i * 8) = w; }
}

__device__ void cvt_f32_fp8(const float* src, unsigned char* dst, size_t n16, float scale) {
    for (size_t i = (size_t)blockIdx.x * blockDim.x + threadIdx.x; i < n16; i += (size_t)gridDim.x * blockDim.x) {
        u32x4 w;
#pragma unroll
        for (int k = 0; k < 4; ++k) { const float4 a = *(const float4*)(src + i * 16 + 4 * k);
            const float x0 = fminf(fmaxf(a.x * scale, -440.f), 440.f), x1 = fminf(fmaxf(a.y * scale, -440.f), 440.f), x2 = fminf(fmaxf(a.z * scale, -440.f), 440.f), x3 = fminf(fmaxf(a.w * scale, -440.f), 440.f);
            int v = __builtin_amdgcn_cvt_pk_fp8_f32(x0, x1, 0, false); v = __builtin_amdgcn_cvt_pk_fp8_f32(x2, x3, v, true); w[k] = (unsigned)v; }
        *(u32x4*)(dst + i * 16) = w; }
}

__device__ void ph_scans(const Params& p) {
    const int wid = threadIdx.x >> 6, lane = threadIdx.x & 63;
    if (wid != 0) return;
    const float* GA = (const float*)(p.ws + OFF_GATES);
    for (int q = blockIdx.x; q < 80; q += gridDim.x) {
        if (q < 64) {
            const int b = q >> 4, h = q & 15; float v[32]; float run = 0.f;
#pragma unroll
            for (int i = 0; i < 32; ++i) { const float z = GA[(size_t)(b * SEQ + 32 * lane + i) * 24 + 8 + h]; run += logsigf_(z); v[i] = run; }
            float inc = run;
#pragma unroll
            for (int o = 1; o < 64; o <<= 1) { const float t = __shfl_up(inc, o); if (lane >= o) inc += t; }
            const float excl = inc - run; float* F = (float*)(p.ws + OFF_FOXF) + (size_t)(b * 16 + h) * SEQ + 32 * lane;
#pragma unroll
            for (int i = 0; i < 32; ++i) F[i] = (v[i] + excl) * 1.4426950408889634f;
        } else {
            const int b = (q - 64) >> 2, h = (q - 64) & 3; float v[32]; float run = 0.f;
#pragma unroll
            for (int i = 0; i < 32; ++i) { const float z = GA[(size_t)(b * SEQ + 32 * lane + i) * 24 + 4 + h]; run += logsigf_(z); v[i] = run; }
            float inc = run;
#pragma unroll
            for (int o = 1; o < 64; o <<= 1) { const float t = __shfl_up(inc, o); if (lane >= o) inc += t; }
            const float excl = inc - run;
            float* FC = (float*)(p.ws + OFF_MLFC) + (size_t)(b * 4 + h) * SEQ + 32 * lane;
            float* BI = (float*)(p.ws + OFF_MLB) + (size_t)(b * 4 + h) * SEQ + 32 * lane;
            float* MP = (float*)(p.ws + OFF_MLMP) + (size_t)(b * 4 + h) * SEQ + 32 * lane;
            float rmax = -INFINITY;
#pragma unroll
            for (int i = 0; i < 32; ++i) { const float fc = v[i] + excl; FC[i] = fc * 1.4426950408889634f; const float ip = GA[(size_t)(b * SEQ + 32 * lane + i) * 24 + h];
                const float bi = ip - fc; BI[i] = bi * 1.4426950408889634f; rmax = fmaxf(rmax, bi); v[i] = rmax; }
            float incm = rmax;
#pragma unroll
            for (int o = 1; o < 64; o <<= 1) { const float t = __shfl_up(incm, o); if (lane >= o) incm = fmaxf(incm, t); }
            float exm = __shfl_up(incm, 1); if (lane == 0) exm = -INFINITY;
#pragma unroll
            for (int i = 0; i < 32; ++i) MP[i] = fmaxf(v[i], exm) * 1.4426950408889634f;
        }
    }
}

__device__ void ph_conv(const Params& p) {
    const bf16_t* P1 = (const bf16_t*)(p.ws + OFF_P1); bf16_t* QKc = (bf16_t*)(p.ws + OFF_QKC);
    const int nthr = gridDim.x * blockDim.x;
    for (int i0 = blockIdx.x * blockDim.x + threadIdx.x; i0 < T_TOK * 256; i0 += 4 * nthr) {
        u32x4 r[4][4]; bool ok[4];
#pragma unroll
        for (int u = 0; u < 4; ++u) { const int i = i0 + u * nthr; ok[u] = i < T_TOK * 256; const int tok = i >> 8, c8 = (i & 255) * 8, s = tok & (SEQ - 1);
#pragma unroll
            for (int j = 0; j < 4; ++j) r[u][j] = (ok[u] && s - 3 + j >= 0) ? *(const u32x4*)(P1 + (size_t)(tok - 3 + j) * P1_LD + c8) : (u32x4){0u, 0u, 0u, 0u}; }
#pragma unroll
        for (int u = 0; u < 4; ++u) { if (!ok[u]) continue;
            const int i = i0 + u * nthr; const int tok = i >> 8, c8 = (i & 255) * 8;
            float acc[8];
            { const float4 b0 = *(const float4*)(p.conv_b + c8), b1 = *(const float4*)(p.conv_b + c8 + 4);
              acc[0] = b0.x; acc[1] = b0.y; acc[2] = b0.z; acc[3] = b0.w; acc[4] = b1.x; acc[5] = b1.y; acc[6] = b1.z; acc[7] = b1.w; }
#pragma unroll
            for (int j = 0; j < 4; ++j) {
                const float4 w0 = *(const float4*)(p.conv_w + j * 2048 + c8), w1 = *(const float4*)(p.conv_w + j * 2048 + c8 + 4);
                acc[0] += w0.x * bflo(r[u][j].x); acc[1] += w0.y * bfhi(r[u][j].x); acc[2] += w0.z * bflo(r[u][j].y); acc[3] += w0.w * bfhi(r[u][j].y);
                acc[4] += w1.x * bflo(r[u][j].z); acc[5] += w1.y * bfhi(r[u][j].z); acc[6] += w1.z * bflo(r[u][j].w); acc[7] += w1.w * bfhi(r[u][j].w);
            }
            const float sc = c8 >= 1024 ? 0.0625f : 1.0f;
#pragma unroll
            for (int e = 0; e < 8; ++e) acc[e] = acc[e] * sigmoidf_(acc[e]) * sc;
            u32x4 w; w.x = cvt_pk_bf16(acc[0], acc[1]); w.y = cvt_pk_bf16(acc[2], acc[3]); w.z = cvt_pk_bf16(acc[4], acc[5]); w.w = cvt_pk_bf16(acc[6], acc[7]);
            *(u32x4*)(QKc + (size_t)tok * DM + c8) = w; }
    }
}

template <int DQ, int DVT, int MODE, int QW>
__device__ __forceinline__ void attn_item(const Params& p, unsigned char* lds_, int b, int h, int qblk, int dvh) {
    constexpr int KLD = DQ + 8, VLD = 72, TILE_E = 64 * KLD + DVT * VLD, BQ = 128 * QW;
    bf16_t* Ks = (bf16_t*)lds_;
    bf16_t* Vs = Ks + 64 * KLD;
    const int tid = threadIdx.x, wid = tid >> 6, lane = tid & 63, n = lane & 15, g = lane >> 4;
    const int q0 = qblk * BQ, wq0 = q0 + 16 * QW * wid;
    const bf16_t* Qp; const bf16_t* Kbase; const bf16_t* VTb; const float* kbias; int ldk, ldq;
    if (MODE == 0) { const bf16_t* P1 = (const bf16_t*)(p.ws + OFF_P1);
        Qp = P1 + ((size_t)b * SEQ + wq0 + n) * P1_LD + 4096 + h * 128; ldq = P1_LD; Kbase = P1 + (size_t)b * SEQ * P1_LD + 6144 + h * 128; ldk = P1_LD;
        VTb = (const bf16_t*)(p.ws + OFF_VT) + (size_t)(2048 + h * 128) * T_TOK + (size_t)b * SEQ;
        kbias = (const float*)(p.ws + OFF_FOXF) + (size_t)(b * 16 + h) * SEQ;
    } else { const bf16_t* QKc = (const bf16_t*)(p.ws + OFF_QKC);
        Qp = QKc + ((size_t)b * SEQ + wq0 + n) * DM + h * 256; ldq = DM; Kbase = QKc + (size_t)b * SEQ * DM + 1024 + h * 256; ldk = DM;
        VTb = (const bf16_t*)(p.ws + OFF_VT) + (size_t)(h * 512 + dvh * 256) * T_TOK + (size_t)b * SEQ;
        kbias = (const float*)(p.ws + OFF_MLB) + (size_t)(b * 4 + h) * SEQ;
    }
    bf16x8 qf[QW][DQ / 32];
#pragma unroll
    for (int qi = 0; qi < QW; ++qi)
#pragma unroll
        for (int ks = 0; ks < DQ / 32; ++ks) qf[qi][ks] = *(const bf16x8*)(Qp + (size_t)(16 * qi) * ldq + ks * 32 + g * 8);
    f32x4 O[QW][DVT / 16];
    float m_run[QW], l_part[QW], mp_t[QW];
#pragma unroll
    for (int qi = 0; qi < QW; ++qi) { m_run[qi] = -INFINITY; l_part[qi] = 0.f;
        mp_t[qi] = (MODE == 1) ? ((const float*)(p.ws + OFF_MLMP))[(size_t)(b * 4 + h) * SEQ + wq0 + 16 * qi + n] : 0.f;
#pragma unroll
        for (int i = 0; i < DVT / 16; ++i) O[qi][i] = (f32x4){0.f, 0.f, 0.f, 0.f}; }
    const float F0 = (MODE == 0) ? kbias[q0] : 0.f;
    const float scale = 0.08838834764831845f * 1.4426950408889634f;
    const int nkb = (q0 + BQ) / 64;
    u32x4 kreg[DQ / 64], vreg[DVT / 64];
#define ATT_LOAD(k0_) do { _Pragma("unroll") for (int i = 0; i < DQ / 64; ++i) { const int q = tid + 512 * i, row = q / (DQ / 8), cc = q % (DQ / 8); \
            kreg[i] = *(const u32x4*)(Kbase + (size_t)((k0_) + row) * ldk + cc * 8); } \
        _Pragma("unroll") for (int i = 0; i < DVT / 64; ++i) { const int q = tid + 512 * i, d = q >> 3, cc = q & 7; \
            vreg[i] = *(const u32x4*)(VTb + (size_t)d * T_TOK + (k0_) + cc * 8); } } while (0)
#define ATT_STORE(buf_) do { bf16_t* Kd = Ks + (buf_) * TILE_E; bf16_t* Vd = Vs + (buf_) * TILE_E; \
        _Pragma("unroll") for (int i = 0; i < DQ / 64; ++i) { const int q = tid + 512 * i, row = q / (DQ / 8), cc = q % (DQ / 8); *(u32x4*)(Kd + row * KLD + cc * 8) = kreg[i]; } \
        _Pragma("unroll") for (int i = 0; i < DVT / 64; ++i) { const int q = tid + 512 * i, d = q >> 3, cc = q & 7; *(u32x4*)(Vd + d * VLD + cc * 8) = vreg[i]; } } while (0)
    int kb_lo = 0, kb_w = 0;
    { const int l1 = lane + 1; const float* mono = (MODE == 0) ? kbias : (const float*)(p.ws + OFF_MLMP) + (size_t)(b * 4 + h) * SEQ;
      const float sg = (MODE == 0) ? 1.0f : -1.0f;
      const float ref0 = mono[q0], refw = mono[wq0];
      const float vi = (64 * l1 <= wq0) ? mono[64 * l1 - 1] : 0.f;
      const bool c0 = (64 * l1 <= q0) && (sg * (ref0 - vi) < -69.25f), cw = (64 * l1 <= wq0) && (sg * (refw - vi) < -69.25f);
      kb_lo = (int)__builtin_popcountll(__builtin_amdgcn_ballot_w64(c0)); kb_w = (int)__builtin_popcountll(__builtin_amdgcn_ballot_w64(cw)); }
    ATT_LOAD(64 * kb_lo);
    __syncthreads();
    ATT_STORE(0);
    if (kb_lo + 1 < nkb) ATT_LOAD(64 * kb_lo + 64);
    __syncthreads();
    for (int kb = kb_lo; kb < nkb; ++kb) {
        const int k0 = kb * 64, cur = (kb - kb_lo) & 1;
        if (kb + 1 < nkb) { ATT_STORE(cur ^ 1); if (kb + 2 < nkb) ATT_LOAD(k0 + 128); }
        const bf16_t* Kc = Ks + cur * TILE_E; const bf16_t* Vc = Vs + cur * TILE_E;
        if (k0 <= wq0 + 16 * QW - 1 && kb >= kb_w) {
            f32x4 S[QW][4];
#pragma unroll
            for (int kt = 0; kt < 4; ++kt) {
#pragma unroll
                for (int qi = 0; qi < QW; ++qi) S[qi][kt] = (f32x4){0.f, 0.f, 0.f, 0.f};
#pragma unroll
                for (int ks = 0; ks < DQ / 32; ++ks) { const bf16x8 a = *(const bf16x8*)(Kc + (16 * kt + n) * KLD + ks * 32 + g * 8);
#pragma unroll
                    for (int qi = 0; qi < QW; ++qi) S[qi][kt] = __builtin_amdgcn_mfma_f32_16x16x32_bf16(a, qf[qi][ks], S[qi][kt], 0, 0, 0); } }
            const bool need_mask = (k0 + 63 > wq0);
            bf16x8 pf[QW][2];
#pragma unroll
            for (int qi = 0; qi < QW; ++qi) {
                const int t = wq0 + 16 * qi + n;
                float pv[4][4];
                if (MODE == 0) {
                    float mx = -INFINITY;
#pragma unroll
                    for (int kt = 0; kt < 4; ++kt) { const float4 fb = *(const float4*)(kbias + k0 + 16 * kt + 4 * g); const float fbv[4] = {fb.x, fb.y, fb.z, fb.w};
#pragma unroll
                        for (int j = 0; j < 4; ++j) { const int s = k0 + 16 * kt + 4 * g + j; float z = S[qi][kt][j] * scale + (F0 - fbv[j]); if (need_mask) z = (s > t) ? -INFINITY : z; pv[kt][j] = z; mx = fmaxf(mx, z); } }
                    mx = fmaxf(mx, __shfl_xor(mx, 16)); mx = fmaxf(mx, __shfl_xor(mx, 32));
                    const float m_new = fmaxf(m_run[qi], mx); const float alpha = __builtin_amdgcn_exp2f(m_run[qi] - m_new); m_run[qi] = m_new;
                    float sum = 0.f;
#pragma unroll
                    for (int kt = 0; kt < 4; ++kt)
#pragma unroll
                        for (int j = 0; j < 4; ++j) { const float e = __builtin_amdgcn_exp2f(pv[kt][j] - m_new); pv[kt][j] = e; sum += e; }
                    l_part[qi] = l_part[qi] * alpha + sum;
#pragma unroll
                    for (int i = 0; i < DVT / 16; ++i) O[qi][i] = O[qi][i] * alpha;
                } else {
#pragma unroll
                    for (int kt = 0; kt < 4; ++kt) { const float4 fb = *(const float4*)(kbias + k0 + 16 * kt + 4 * g); const float fbv[4] = {fb.x, fb.y, fb.z, fb.w};
#pragma unroll
                        for (int j = 0; j < 4; ++j) { const int s = k0 + 16 * kt + 4 * g + j; const float e = __builtin_amdgcn_exp2f(fbv[j] - mp_t[qi]) * S[qi][kt][j]; const float pe = (!need_mask || s <= t) ? e : 0.f; pv[kt][j] = pe; l_part[qi] += pe; } }
                }
#pragma unroll
                for (int kk = 0; kk < 2; ++kk) { u32x4 w; w.x = cvt_pk_bf16(pv[2 * kk][0], pv[2 * kk][1]); w.y = cvt_pk_bf16(pv[2 * kk][2], pv[2 * kk][3]);
                    w.z = cvt_pk_bf16(pv[2 * kk + 1][0], pv[2 * kk + 1][1]); w.w = cvt_pk_bf16(pv[2 * kk + 1][2], pv[2 * kk + 1][3]); pf[qi][kk] = __builtin_bit_cast(bf16x8, w); }
            }
#pragma unroll
            for (int dt = 0; dt < DVT / 16; ++dt)
#pragma unroll
                for (int kk = 0; kk < 2; ++kk) { const bf16_t* vp = Vc + (16 * dt + n) * VLD + 32 * kk + 4 * g;
                    const u32x2 lo = *(const u32x2*)vp, hi = *(const u32x2*)(vp + 16); u32x4 w; w.x = lo.x; w.y = lo.y; w.z = hi.x; w.w = hi.y;
#pragma unroll
                    for (int qi = 0; qi < QW; ++qi) O[qi][dt] = __builtin_amdgcn_mfma_f32_16x16x32_bf16(__builtin_bit_cast(bf16x8, w), pf[qi][kk], O[qi][dt], 0, 0, 0); }
        }
        __syncthreads();
    }
#undef ATT_LOAD
#undef ATT_STORE
#pragma unroll
    for (int qi = 0; qi < QW; ++qi) {
        const int t = wq0 + 16 * qi + n; const size_t tokq = (size_t)b * SEQ + t;
        float l = l_part[qi]; l += __shfl_xor(l, 16); l += __shfl_xor(l, 32);
        if (MODE == 0) {
            unsigned char* op8 = p.ws + OFF_YB + tokq * DM + h * 128 + 4 * g; const float sv = (1.0f / l) * XQ_SCALE;
#pragma unroll
            for (int dt = 0; dt < DVT / 16; ++dt) { int a = __builtin_amdgcn_cvt_pk_fp8_f32(clamp8(O[qi][dt][0] * sv), clamp8(O[qi][dt][1] * sv), 0, false); a = __builtin_amdgcn_cvt_pk_fp8_f32(clamp8(O[qi][dt][2] * sv), clamp8(O[qi][dt][3] * sv), a, true); *(int*)(op8 + 16 * dt) = a; }
        } else {
            const float mt = ((const float*)(p.ws + OFF_MLFC))[(size_t)(b * 4 + h) * SEQ + t] + mp_t[qi]; const float inv = 1.0f / fmaxf(fabsf(l), __builtin_amdgcn_exp2f(-mt));
            bf16_t* op = (bf16_t*)(p.ws + OFF_HPRE) + tokq * DM + h * 512 + dvh * 256 + 4 * g;
#pragma unroll
            for (int dt = 0; dt < DVT / 16; ++dt) { u32x2 w; w.x = cvt_pk_bf16(O[qi][dt][0] * inv, O[qi][dt][1] * inv); w.y = cvt_pk_bf16(O[qi][dt][2] * inv, O[qi][dt][3] * inv); *(u32x2*)(op + 16 * dt) = w; }
        }
    }
}

__device__ void ph_mixers(const Params& p, unsigned char* lds_, int rep) {
    int* sitem = (int*)(lds_ + LDS_BYTES - 16);
    unsigned* ctr = (unsigned*)(p.ws + OFF_CTL) + 64 * rep;
    for (;;) {
        __syncthreads();
        if (threadIdx.x == 0) *sitem = (int)atomicAdd(ctr, 1u);
        __syncthreads();
        const int I = *sitem;
        if (I >= 512) break;
        attn_item<128, 128, 0, 2>(p, lds_, I & 3, 15 - ((I & 63) >> 2), 7 - (I >> 6), 0);
    }
    for (;;) {
        __syncthreads();
        if (threadIdx.x == 0) *sitem = (int)atomicAdd(ctr + 16, 1u);
        __syncthreads();
        const int I = *sitem;
        if (I >= 512) break;
        const int ww = I & 31;
        attn_item<256, 256, 1, 1>(p, lds_, ww >> 3, (ww >> 1) & 3, 15 - (I >> 5), ww & 1);
    }
}

__device__ void ph_mlnorm(const Params& p, int blk, int nblk) {
    const int wid = threadIdx.x >> 6, lane = threadIdx.x & 63;
    const bf16_t* HP = (const bf16_t*)(p.ws + OFF_HPRE); const bf16_t* P1 = (const bf16_t*)(p.ws + OFF_P1); unsigned char* HB = p.ws + OFF_HB;
    const int nw = nblk * 8;
    for (int item0 = blk * 8 + wid; item0 < T_TOK * 4; item0 += 2 * nw) {
        u32x4 r[2], og[2]; bool ok[2];
#pragma unroll
        for (int u = 0; u < 2; ++u) { const int item = item0 + u * nw; ok[u] = item < T_TOK * 4; const int tok = item >> 2, h = item & 3;
            if (ok[u]) { r[u] = *(const u32x4*)(HP + (size_t)tok * DM + h * 512 + 8 * lane); og[u] = *(const u32x4*)(P1 + (size_t)tok * P1_LD + 2048 + h * 512 + 8 * lane); } }
#pragma unroll
        for (int u = 0; u < 2; ++u) { if (!ok[u]) continue;
            const int item = item0 + u * nw; const int tok = item >> 2, h = item & 3;
            float v[8] = {bflo(r[u].x), bfhi(r[u].x), bflo(r[u].y), bfhi(r[u].y), bflo(r[u].z), bfhi(r[u].z), bflo(r[u].w), bfhi(r[u].w)};
            float s = 0.f;
#pragma unroll
            for (int e = 0; e < 8; ++e) s += v[e];
            const float mean = wsum(s) * (1.0f / 512.0f);
            float q = 0.f;
#pragma unroll
            for (int e = 0; e < 8; ++e) { v[e] -= mean; q += v[e] * v[e]; }
            const float rstd = rsqrtf(wsum(q) * (1.0f / 512.0f) + LN_EPS);
            const float o[8] = {bflo(og[u].x), bfhi(og[u].x), bflo(og[u].y), bfhi(og[u].y), bflo(og[u].z), bfhi(og[u].z), bflo(og[u].w), bfhi(og[u].w)};
            const float4 n0 = *(const float4*)(p.norm_w + h * 512 + 8 * lane), n1 = *(const float4*)(p.norm_w + h * 512 + 8 * lane + 4);
            const float nwv[8] = {n0.x, n0.y, n0.z, n0.w, n1.x, n1.y, n1.z, n1.w};
            float y[8];
#pragma unroll
            for (int e = 0; e < 8; ++e) y[e] = v[e] * rstd * nwv[e] * sigmoidf_(o[e]);
            u32x2 w;
            { int a = __builtin_amdgcn_cvt_pk_fp8_f32(clamp8(y[0] * XQ_SCALE), clamp8(y[1] * XQ_SCALE), 0, false); a = __builtin_amdgcn_cvt_pk_fp8_f32(clamp8(y[2] * XQ_SCALE), clamp8(y[3] * XQ_SCALE), a, true);
              int b = __builtin_amdgcn_cvt_pk_fp8_f32(clamp8(y[4] * XQ_SCALE), clamp8(y[5] * XQ_SCALE), 0, false); b = __builtin_amdgcn_cvt_pk_fp8_f32(clamp8(y[6] * XQ_SCALE), clamp8(y[7] * XQ_SCALE), b, true); w.x = (unsigned)a; w.y = (unsigned)b; }
            *(u32x2*)(HB + (size_t)tok * DM + h * 512 + 8 * lane) = w; }
    }
}

__device__ void ph_ln_rows(const bf16_t* pre, const float* w, const float* bb, bf16_t* outb, unsigned char* outq) {
    const int wid = threadIdx.x >> 6, lane = threadIdx.x & 63;
    for (int tok = blockIdx.x * 8 + wid; tok < T_TOK; tok += gridDim.x * 8) {
        float v[4][8]; float s = 0.f;
#pragma unroll
        for (int j = 0; j < 4; ++j) { const u32x4 r = *(const u32x4*)(pre + (size_t)tok * DM + 512 * j + 8 * lane);
            v[j][0] = bflo(r.x); v[j][1] = bfhi(r.x); v[j][2] = bflo(r.y); v[j][3] = bfhi(r.y); v[j][4] = bflo(r.z); v[j][5] = bfhi(r.z); v[j][6] = bflo(r.w); v[j][7] = bfhi(r.w);
#pragma unroll
            for (int e = 0; e < 8; ++e) s += v[j][e]; }
        const float mean = wsum(s) * (1.0f / 2048.0f);
        float q = 0.f;
#pragma unroll
        for (int j = 0; j < 4; ++j)
#pragma unroll
            for (int e = 0; e < 8; ++e) { v[j][e] -= mean; q += v[j][e] * v[j][e]; }
        const float rstd = rsqrtf(wsum(q) * (1.0f / 2048.0f) + LN_EPS);
#pragma unroll
        for (int j = 0; j < 4; ++j) { const int c = 512 * j + 8 * lane;
            const float4 w0 = *(const float4*)(w + c), w1 = *(const float4*)(w + c + 4), b0 = *(const float4*)(bb + c), b1 = *(const float4*)(bb + c + 4);
            float4 y0, y1;
            y0.x = v[j][0] * rstd * w0.x + b0.x; y0.y = v[j][1] * rstd * w0.y + b0.y; y0.z = v[j][2] * rstd * w0.z + b0.z; y0.w = v[j][3] * rstd * w0.w + b0.w;
            y1.x = v[j][4] * rstd * w1.x + b1.x; y1.y = v[j][5] * rstd * w1.y + b1.y; y1.z = v[j][6] * rstd * w1.z + b1.z; y1.w = v[j][7] * rstd * w1.w + b1.w;
            u32x4 pk; pk.x = cvt_pk_bf16(y0.x, y0.y); pk.y = cvt_pk_bf16(y0.z, y0.w); pk.z = cvt_pk_bf16(y1.x, y1.y); pk.w = cvt_pk_bf16(y1.z, y1.w);
            *(u32x4*)(outb + (size_t)tok * DM + c) = pk;
            if (outq) { int a = __builtin_amdgcn_cvt_pk_fp8_f32(clamp8(y0.x * XQ_SCALE), clamp8(y0.y * XQ_SCALE), 0, false); a = __builtin_amdgcn_cvt_pk_fp8_f32(clamp8(y0.z * XQ_SCALE), clamp8(y0.w * XQ_SCALE), a, true);
                int b = __builtin_amdgcn_cvt_pk_fp8_f32(clamp8(y1.x * XQ_SCALE), clamp8(y1.y * XQ_SCALE), 0, false); b = __builtin_amdgcn_cvt_pk_fp8_f32(clamp8(y1.z * XQ_SCALE), clamp8(y1.w * XQ_SCALE), b, true);
                u32x2 q8; q8.x = (unsigned)a; q8.y = (unsigned)b; *(u32x2*)(outq + (size_t)tok * DM + c) = q8; } }
    }
}

__device__ __forceinline__ void xattn_item(const Params& p, unsigned char* lds_, int b, int h, int qblk) {
    constexpr int KLD = 72, VLD = 264;
    bf16_t* Ks = (bf16_t*)lds_;
    bf16_t* Vs = Ks + 256 * KLD;
    const int tid = threadIdx.x, wid = tid >> 6, lane = tid & 63, n = lane & 15, g = lane >> 4;
    const size_t tokq = (size_t)b * SEQ + qblk * 128 + 16 * wid + n;
    const bf16_t* Qp = (const bf16_t*)(p.ws + OFF_QX) + tokq * DM + h * 512;
    const bf16_t* Kc = (const bf16_t*)(p.ws + OFF_KC) + (size_t)b * 256 * DM + h * 512;
    const bf16_t* VcT = (const bf16_t*)(p.ws + OFF_VCT) + (size_t)(h * 512) * 1024 + b * 256;
    f32x4 S[16];
#pragma unroll
    for (int i = 0; i < 16; ++i) S[i] = (f32x4){0.f, 0.f, 0.f, 0.f};
    u32x4 kreg[4]; bf16x8 qnext[2];
#pragma unroll
    for (int i = 0; i < 4; ++i) { const int q = tid + 512 * i, row = q >> 3, cc = q & 7; kreg[i] = *(const u32x4*)(Kc + (size_t)row * DM + cc * 8); }
#pragma unroll
    for (int ks = 0; ks < 2; ++ks) qnext[ks] = *(const bf16x8*)(Qp + ks * 32 + g * 8);
    for (int dc = 0; dc < 8; ++dc) {
        __syncthreads();
#pragma unroll
        for (int i = 0; i < 4; ++i) { const int q = tid + 512 * i, row = q >> 3, cc = q & 7; *(u32x4*)(Ks + row * KLD + cc * 8) = kreg[i]; }
        bf16x8 qf[2]; qf[0] = qnext[0]; qf[1] = qnext[1];
        __syncthreads();
        if (dc + 1 < 8) {
#pragma unroll
            for (int i = 0; i < 4; ++i) { const int q = tid + 512 * i, row = q >> 3, cc = q & 7; kreg[i] = *(const u32x4*)(Kc + (size_t)row * DM + (dc + 1) * 64 + cc * 8); }
#pragma unroll
            for (int ks = 0; ks < 2; ++ks) qnext[ks] = *(const bf16x8*)(Qp + (dc + 1) * 64 + ks * 32 + g * 8);
        }
#pragma unroll
        for (int kt = 0; kt < 16; ++kt)
#pragma unroll
            for (int ks = 0; ks < 2; ++ks) { const bf16x8 a = *(const bf16x8*)(Ks + (16 * kt + n) * KLD + ks * 32 + g * 8);
                S[kt] = __builtin_amdgcn_mfma_f32_16x16x32_bf16(a, qf[ks], S[kt], 0, 0, 0); }
    }
    const float scale = 0.04419417382415922f;
    float mx = -INFINITY;
#pragma unroll
    for (int kt = 0; kt < 16; ++kt)
#pragma unroll
        for (int j = 0; j < 4; ++j) { S[kt][j] *= scale; mx = fmaxf(mx, S[kt][j]); }
    mx = fmaxf(mx, __shfl_xor(mx, 16)); mx = fmaxf(mx, __shfl_xor(mx, 32));
    float l = 0.f;
#pragma unroll
    for (int kt = 0; kt < 16; ++kt)
#pragma unroll
        for (int j = 0; j < 4; ++j) { const float e = __expf(S[kt][j] - mx); S[kt][j] = e; l += e; }
    l += __shfl_xor(l, 16); l += __shfl_xor(l, 32);
    const float inv = 1.0f / l;
    bf16x8 pf[8];
#pragma unroll
    for (int kk = 0; kk < 8; ++kk) { u32x4 w; w.x = cvt_pk_bf16(S[2 * kk][0], S[2 * kk][1]); w.y = cvt_pk_bf16(S[2 * kk][2], S[2 * kk][3]);
        w.z = cvt_pk_bf16(S[2 * kk + 1][0], S[2 * kk + 1][1]); w.w = cvt_pk_bf16(S[2 * kk + 1][2], S[2 * kk + 1][3]); pf[kk] = __builtin_bit_cast(bf16x8, w); }
    bf16_t* op = (bf16_t*)(p.ws + OFF_OB) + tokq * DM + h * 512 + 4 * g;
    u32x4 vreg[8];
#pragma unroll
    for (int i = 0; i < 8; ++i) { const int q = tid + 512 * i, d = q >> 5, cc = q & 31; vreg[i] = *(const u32x4*)(VcT + (size_t)d * 1024 + cc * 8); }
    for (int dvc = 0; dvc < 4; ++dvc) {
        __syncthreads();
#pragma unroll
        for (int i = 0; i < 8; ++i) { const int q = tid + 512 * i, d = q >> 5, cc = q & 31; *(u32x4*)(Vs + d * VLD + cc * 8) = vreg[i]; }
        __syncthreads();
        if (dvc + 1 < 4) {
#pragma unroll
            for (int i = 0; i < 8; ++i) { const int q = tid + 512 * i, d = q >> 5, cc = q & 31; vreg[i] = *(const u32x4*)(VcT + (size_t)((dvc + 1) * 128 + d) * 1024 + cc * 8); }
        }
        f32x4 O[8];
#pragma unroll
        for (int dt = 0; dt < 8; ++dt) { O[dt] = (f32x4){0.f, 0.f, 0.f, 0.f};
#pragma unroll
            for (int kk = 0; kk < 8; ++kk) { const bf16_t* vp = Vs + (16 * dt + n) * VLD + 32 * kk + 4 * g;
                const u32x2 lo = *(const u32x2*)vp, hi = *(const u32x2*)(vp + 16); u32x4 w; w.x = lo.x; w.y = lo.y; w.z = hi.x; w.w = hi.y;
                O[dt] = __builtin_amdgcn_mfma_f32_16x16x32_bf16(__builtin_bit_cast(bf16x8, w), pf[kk], O[dt], 0, 0, 0); } }
        { const float sv = inv * OQ_SCALE; unsigned char* op8 = p.ws + OFF_OB + tokq * DM + h * 512 + 4 * g + dvc * 128;
#pragma unroll
          for (int dt = 0; dt < 8; ++dt) { int a = __builtin_amdgcn_cvt_pk_fp8_f32(clamp8(O[dt][0] * sv), clamp8(O[dt][1] * sv), 0, false); a = __builtin_amdgcn_cvt_pk_fp8_f32(clamp8(O[dt][2] * sv), clamp8(O[dt][3] * sv), a, true);
              *(int*)(op8 + 16 * dt) = a; } }
    }
}

__device__ __forceinline__ unsigned ordf(float f) { const unsigned u = __float_as_uint(f); return (u & 0x80000000u) ? ~u : (u | 0x80000000u); }

__device__ __forceinline__ unsigned dpp_max_u32(unsigned v) {
    unsigned t;
    t = (unsigned)__builtin_amdgcn_update_dpp(0, (int)v, 0x111, 0xf, 0xf, true); v = v > t ? v : t;
    t = (unsigned)__builtin_amdgcn_update_dpp(0, (int)v, 0x112, 0xf, 0xf, true); v = v > t ? v : t;
    t = (unsigned)__builtin_amdgcn_update_dpp(0, (int)v, 0x114, 0xf, 0xf, true); v = v > t ? v : t;
    t = (unsigned)__builtin_amdgcn_update_dpp(0, (int)v, 0x118, 0xf, 0xf, true); v = v > t ? v : t;
    t = (unsigned)__builtin_amdgcn_update_dpp(0, (int)v, 0x142, 0xa, 0xf, false); v = v > t ? v : t;
    t = (unsigned)__builtin_amdgcn_update_dpp(0, (int)v, 0x143, 0xc, 0xf, false); v = v > t ? v : t;
    return (unsigned)__builtin_amdgcn_readlane((int)v, 63);
}
__device__ __forceinline__ float rdlane_f(float v, int l) { return __int_as_float(__builtin_amdgcn_readlane(__float_as_int(v), l)); }

__device__ __forceinline__ void split_bf16x8(const float4 a, const float4 b, bf16x8& hi, bf16x8& lo) {
    u32x4 h, l;
    h.x = cvt_pk_bf16(a.x, a.y); h.y = cvt_pk_bf16(a.z, a.w); h.z = cvt_pk_bf16(b.x, b.y); h.w = cvt_pk_bf16(b.z, b.w);
    l.x = cvt_pk_bf16(a.x - bflo(h.x), a.y - bfhi(h.x)); l.y = cvt_pk_bf16(a.z - bflo(h.y), a.w - bfhi(h.y));
    l.z = cvt_pk_bf16(b.x - bflo(h.z), b.y - bfhi(h.z)); l.w = cvt_pk_bf16(b.z - bflo(h.w), b.w - bfhi(h.w));
    hi = __builtin_bit_cast(bf16x8, h); lo = __builtin_bit_cast(bf16x8, l);
}

__device__ __forceinline__ float unordf(unsigned w) { return __uint_as_float((w & 0x80000000u) ? (w & 0x7fffffffu) : ~w); }
__device__ __forceinline__ unsigned umax_(unsigned a, unsigned b) { return a > b ? a : b; }
__device__ __forceinline__ unsigned xg_max(unsigned m) {
    m = umax_(m, (unsigned)__shfl_xor((int)m, 16)); m = umax_(m, (unsigned)__shfl_xor((int)m, 32)); return m; }
__device__ __forceinline__ int cndm(int f, int t, unsigned long long m) { int r; asm("v_cndmask_b32 %0, %1, %2, %3" : "=v"(r) : "v"(f), "v"(t), "s"(m)); return r; }
__device__ __forceinline__ int sel16(const int (&t)[16], int i) {
    const unsigned long long m0 = __builtin_amdgcn_ballot_w64((i & 1) != 0), m1 = __builtin_amdgcn_ballot_w64((i & 2) != 0), m2 = __builtin_amdgcn_ballot_w64((i & 4) != 0), m3 = __builtin_amdgcn_ballot_w64((i & 8) != 0);
    int a[8];
#pragma unroll
    for (int k = 0; k < 8; ++k) a[k] = cndm(t[2 * k], t[2 * k + 1], m0);
    int c[4];
#pragma unroll
    for (int k = 0; k < 4; ++k) c[k] = cndm(a[2 * k], a[2 * k + 1], m1);
    const int d0 = cndm(c[0], c[1], m2), d1 = cndm(c[2], c[3], m2);
    return cndm(d0, d1, m3); }

__device__ void ph_peer_score(const Params& p, unsigned char* lds_) {
    constexpr int KLD = 136;
    const int tid = threadIdx.x, wid = tid >> 6, lane = tid & 63, n = lane & 15, g = lane >> 4;
    bf16_t* KH = (bf16_t*)lds_;
    bf16_t* KL = KH + 2 * 128 * KLD;
    const float* QP = (const float*)(p.ws + OFF_QP);
    int* IDX = (int*)(p.ws + OFF_IDX); float* GG = (float*)(p.ws + OFF_G);
    for (int unit = blockIdx.x; unit < 256; unit += gridDim.x) {
        const int h = unit & 7, chunk = unit >> 3;
        __syncthreads();
        { float4 kv[16];
#pragma unroll
          for (int it = 0; it < 16; ++it) kv[it] = *(const float4*)(p.sub_keys + (size_t)h * 32768 + 4 * (tid + 512 * it));
#pragma unroll
          for (int it = 0; it < 16; ++it) { const int e = 4 * (tid + 512 * it), pn = e >> 7, d = e & 127;
              const unsigned h0 = cvt_pk_bf16(kv[it].x, kv[it].y), h1 = cvt_pk_bf16(kv[it].z, kv[it].w);
              const unsigned l0 = cvt_pk_bf16(kv[it].x - bflo(h0), kv[it].y - bfhi(h0)), l1 = cvt_pk_bf16(kv[it].z - bflo(h1), kv[it].w - bfhi(h1));
              u32x2 hw; hw.x = h0; hw.y = h1; u32x2 lw; lw.x = l0; lw.y = l1;
              *(u32x2*)(KH + pn * KLD + d) = hw; *(u32x2*)(KL + pn * KLD + d) = lw; } }
        __syncthreads();
        for (int grp = 0; grp < 2; ++grp) {
            const int tok = chunk * 256 + wid * 32 + grp * 16 + n;
            unsigned pk[2][32];
#pragma unroll
            for (int pp = 0; pp < 2; ++pp) {
                bf16x8 qh[4], ql[4];
                const float* qp = QP + (size_t)tok * DM + h * 256 + pp * 128 + g * 8;
#pragma unroll
                for (int ks = 0; ks < 4; ++ks) split_bf16x8(*(const float4*)(qp + ks * 32), *(const float4*)(qp + ks * 32 + 4), qh[ks], ql[ks]);
#pragma unroll
                for (int kt = 0; kt < 8; ++kt) { f32x4 acc = (f32x4){0.f, 0.f, 0.f, 0.f};
#pragma unroll
                    for (int ks = 0; ks < 4; ++ks) { const int off = (pp * 128 + 16 * kt + n) * KLD + ks * 32 + g * 8;
                        const bf16x8 ah = *(const bf16x8*)(KH + off), al = *(const bf16x8*)(KL + off);
                        acc = __builtin_amdgcn_mfma_f32_16x16x32_bf16(al, qh[ks], acc, 0, 0, 0);
                        acc = __builtin_amdgcn_mfma_f32_16x16x32_bf16(ah, ql[ks], acc, 0, 0, 0);
                        acc = __builtin_amdgcn_mfma_f32_16x16x32_bf16(ah, qh[ks], acc, 0, 0, 0); }
#pragma unroll
                    for (int j = 0; j < 4; ++j) pk[pp][kt * 4 + j] = (ordf(acc[j]) & ~127u) | (unsigned)(127 - (16 * kt + 4 * g + j)); }
            }
            unsigned tw[2][16];
#pragma unroll
            for (int r = 0; r < 16; ++r) {
#pragma unroll
                for (int pp = 0; pp < 2; ++pp) { unsigned m = pk[pp][0];
#pragma unroll
                    for (int i = 1; i < 32; ++i) m = umax_(m, pk[pp][i]);
                    m = xg_max(m); tw[pp][r] = m;
#pragma unroll
                    for (int i = 0; i < 32; ++i) pk[pp][i] = (pk[pp][i] == m) ? 0u : pk[pp][i]; }
            }
            float av[16]; int ti0[16], ti1[16];
#pragma unroll
            for (int i = 0; i < 16; ++i) { av[i] = unordf(tw[0][i] & ~127u); ti0[i] = 127 - (int)(tw[0][i] & 127u); ti1[i] = 127 - (int)(tw[1][i] & 127u); }
            float bv[4];
#pragma unroll
            for (int jj = 0; jj < 4; ++jj) { const unsigned t = g == 0 ? tw[1][4 * jj] : g == 1 ? tw[1][4 * jj + 1] : g == 2 ? tw[1][4 * jj + 2] : tw[1][4 * jj + 3]; bv[jj] = unordf(t & ~127u); }
            unsigned cp[21];
#pragma unroll
            for (int i = 0; i < 16; ++i) cp[i] = (ordf(av[i] + bv[0]) & ~255u) | (unsigned)(255 - (16 * i + g));
#pragma unroll
            for (int i = 0; i < 3; ++i) cp[16 + i] = (ordf(av[i] + bv[1]) & ~255u) | (unsigned)(255 - (16 * i + 4 + g));
            cp[19] = (ordf(av[0] + bv[2]) & ~255u) | (unsigned)(255 - (8 + g));
            cp[20] = (ordf(av[0] + bv[3]) & ~255u) | (unsigned)(255 - (12 + g));
            unsigned cw[16];
#pragma unroll
            for (int r = 0; r < 16; ++r) { unsigned m = cp[0];
#pragma unroll
                for (int i = 1; i < 21; ++i) m = umax_(m, cp[i]);
                m = xg_max(m); cw[r] = m;
#pragma unroll
                for (int i = 0; i < 21; ++i) cp[i] = (cp[i] == m) ? 0u : cp[i]; }
            float sv[16]; int ev[16]; float mx = -INFINITY;
#pragma unroll
            for (int r = 0; r < 16; ++r) { const int cid = 255 - (int)(cw[r] & 255u); ev[r] = sel16(ti0, cid >> 4) * 128 + sel16(ti1, cid & 15); sv[r] = unordf(cw[r] & ~255u); mx = fmaxf(mx, sv[r]); }
            float sm = 0.f;
#pragma unroll
            for (int r = 0; r < 16; ++r) { sv[r] = __expf(sv[r] - mx); sm += sv[r]; }
            const float rs = 1.0f / sm;
            if (g == 0) {
                int* ip = IDX + (size_t)tok * 128 + h * 16; float* gp = GG + (size_t)tok * 128 + h * 16;
#pragma unroll
                for (int r4 = 0; r4 < 4; ++r4) { *(int4*)(ip + 4 * r4) = make_int4(ev[4 * r4], ev[4 * r4 + 1], ev[4 * r4 + 2], ev[4 * r4 + 3]);
                    *(float4*)(gp + 4 * r4) = make_float4(sv[4 * r4] * rs, sv[4 * r4 + 1] * rs, sv[4 * r4 + 2] * rs, sv[4 * r4 + 3] * rs); }
            }
        }
    }
    __syncthreads();
}

constexpr float U_SCALE = 256.0f, V_SCALE = 16.0f;
__device__ __forceinline__ float dot16(const u32x4 r, const float* x) {
    float d = 0.f;
#pragma unroll
    for (int k = 0; k < 4; ++k) { const f32x2 lo = __builtin_amdgcn_cvt_pk_f32_fp8((int)r[k], false), hi = __builtin_amdgcn_cvt_pk_f32_fp8((int)r[k], true);
        d += x[4 * k] * lo.x + x[4 * k + 1] * lo.y + x[4 * k + 2] * hi.x + x[4 * k + 3] * hi.y; }
    return d; }
__device__ __forceinline__ void axpy16(float* a, const float hv, const u32x4 r) {
#pragma unroll
    for (int k = 0; k < 4; ++k) { const f32x2 lo = __builtin_amdgcn_cvt_pk_f32_fp8((int)r[k], false), hi = __builtin_amdgcn_cvt_pk_f32_fp8((int)r[k], true);
        a[4 * k] += hv * lo.x; a[4 * k + 1] += hv * lo.y; a[4 * k + 2] += hv * hi.x; a[4 * k + 3] += hv * hi.y; } }

__device__ void ph_peer_gather(const Params& p) {
    constexpr int UN = 4;
    const int wid = threadIdx.x >> 6, lane = threadIdx.x & 63;
    const bf16_t* X2 = (const bf16_t*)(p.ws + OFF_X2B);
    const int* IDX = (const int*)(p.ws + OFF_IDX); const float* GG = (const float*)(p.ws + OFF_G);
    const unsigned char* UB = p.ws + OFF_UB; const unsigned char* VB = p.ws + OFF_VB;
    const float* lw = p.ln_w + 2 * DM; const float* lb = p.ln_b + 2 * DM;
    for (int tok = blockIdx.x * 8 + wid; tok < T_TOK; tok += gridDim.x * 8) {
        int lo16 = 16 * lane; asm volatile("" : "+v"(lo16));
        float xv[2][16];
#pragma unroll
        for (int j = 0; j < 2; ++j)
#pragma unroll
            for (int k = 0; k < 2; ++k) { const u32x4 a = *(const u32x4*)(X2 + (size_t)tok * DM + 1024 * j + lo16 + 8 * k);
                xv[j][8 * k] = bflo(a.x); xv[j][8 * k + 1] = bfhi(a.x); xv[j][8 * k + 2] = bflo(a.y); xv[j][8 * k + 3] = bfhi(a.y); xv[j][8 * k + 4] = bflo(a.z); xv[j][8 * k + 5] = bfhi(a.z); xv[j][8 * k + 6] = bflo(a.w); xv[j][8 * k + 7] = bfhi(a.w); }
        int idr[2]; float gr[2], ar[2] = {0.f, 0.f};
        idr[0] = IDX[(size_t)tok * 128 + lane]; idr[1] = IDX[(size_t)tok * 128 + 64 + lane];
        gr[0] = GG[(size_t)tok * 128 + lane]; gr[1] = GG[(size_t)tok * 128 + 64 + lane];
#pragma unroll
        for (int half = 0; half < 2; ++half) {
#pragma unroll 1
            for (int e = 0; e < 64; e += UN) {
                u32x4 r[UN][2];
#pragma unroll
                for (int u = 0; u < UN; ++u) { const int id = __builtin_amdgcn_readlane(idr[half], e + u); const unsigned char* rp = UB + (size_t)id * DM + lo16;
                    r[u][0] = *(const u32x4*)rp; r[u][1] = *(const u32x4*)(rp + 1024); }
#pragma unroll
                for (int u = 0; u < UN; ++u) { float d = dot16(r[u][0], xv[0]) + dot16(r[u][1], xv[1]);
                    d = wsum(d);
                    if (lane == e + u) ar[half] = d * (1.0f / U_SCALE);
                    __builtin_amdgcn_sched_barrier(0); }
            }
        }
        float hr[2];
#pragma unroll
        for (int half = 0; half < 2; ++half) hr[half] = 0.5f * ar[half] * (1.0f + erff(ar[half] * 0.70710678118654752f)) * gr[half] * (1.0f / V_SCALE);
        float acc[2][16];
#pragma unroll
        for (int j = 0; j < 2; ++j)
#pragma unroll
            for (int e = 0; e < 16; ++e) acc[j][e] = 0.f;
#pragma unroll
        for (int half = 0; half < 2; ++half) {
#pragma unroll 1
            for (int e = 0; e < 64; e += UN) {
                u32x4 r[UN][2]; float hv[UN];
#pragma unroll
                for (int u = 0; u < UN; ++u) { const int id = __builtin_amdgcn_readlane(idr[half], e + u); hv[u] = __int_as_float(__builtin_amdgcn_readlane(__float_as_int(hr[half]), e + u));
                    const unsigned char* rp = VB + (size_t)id * DM + lo16;
                    r[u][0] = *(const u32x4*)rp; r[u][1] = *(const u32x4*)(rp + 1024); }
#pragma unroll
                for (int u = 0; u < UN; ++u) { axpy16(acc[0], hv[u], r[u][0]); axpy16(acc[1], hv[u], r[u][1]); __builtin_amdgcn_sched_barrier(0); }
            }
        }
        asm volatile("" : "+v"(lo16));
        float s = 0.f;
#pragma unroll
        for (int j = 0; j < 2; ++j)
#pragma unroll
            for (int k = 0; k < 2; ++k) { const u32x4 a = *(const u32x4*)(X2 + (size_t)tok * DM + 1024 * j + lo16 + 8 * k);
                acc[j][8 * k] += DN_ALPHA * bflo(a.x); acc[j][8 * k + 1] += DN_ALPHA * bfhi(a.x); acc[j][8 * k + 2] += DN_ALPHA * bflo(a.y); acc[j][8 * k + 3] += DN_ALPHA * bfhi(a.y);
                acc[j][8 * k + 4] += DN_ALPHA * bflo(a.z); acc[j][8 * k + 5] += DN_ALPHA * bfhi(a.z); acc[j][8 * k + 6] += DN_ALPHA * bflo(a.w); acc[j][8 * k + 7] += DN_ALPHA * bfhi(a.w);
#pragma unroll
                for (int e = 0; e < 8; ++e) s += acc[j][8 * k + e]; }
        const float mean = wsum(s) * (1.0f / 2048.0f);
        float q = 0.f;
#pragma unroll
        for (int j = 0; j < 2; ++j)
#pragma unroll
            for (int e = 0; e < 16; ++e) { acc[j][e] -= mean; q += acc[j][e] * acc[j][e]; }
        const float rstd = rsqrtf(wsum(q) * (1.0f / 2048.0f) + LN_EPS);
#pragma unroll
        for (int j = 0; j < 2; ++j)
#pragma unroll
            for (int k = 0; k < 4; ++k) { const int c = 1024 * j + lo16 + 4 * k;
                const float4 w0 = *(const float4*)(lw + c), b0 = *(const float4*)(lb + c);
                float4 y0;
                y0.x = acc[j][4 * k] * rstd * w0.x + b0.x; y0.y = acc[j][4 * k + 1] * rstd * w0.y + b0.y; y0.z = acc[j][4 * k + 2] * rstd * w0.z + b0.z; y0.w = acc[j][4 * k + 3] * rstd * w0.w + b0.w;
                *(float4*)(p.out + (size_t)tok * DM + c) = y0; }
    }
}

typedef float f32x16 __attribute__((ext_vector_type(16)));
typedef float f32x32 __attribute__((ext_vector_type(32)));
typedef unsigned u32x6 __attribute__((ext_vector_type(6)));
constexpr float U6_SCALE = 64.0f, V6_SCALE = 8.0f;
constexpr int ROW6 = 1536;
__device__ __forceinline__ float clamp6(float x) { return fminf(fmaxf(x, -7.5f), 7.5f); }
__device__ void cvt_f32_fp6(const float* src, unsigned char* dst, size_t n32, float scale, unsigned char* lds_) {
    float* buf = (float*)lds_ + threadIdx.x * 33;
    int pi[32];
    { f32x16 pa, pb;
#pragma unroll
      for (int i = 0; i < 16; ++i) { pa[i] = (float)(i & 7); pb[i] = (float)((16 + i) & 7); }
      const f32x32 d1 = __builtin_amdgcn_cvt_scalef32_pk32_f32_fp6(__builtin_amdgcn_cvt_scalef32_2xpk16_fp6_f32(pa, pb, 1.0f), 1.0f);
#pragma unroll
      for (int i = 0; i < 16; ++i) { pa[i] = (float)(i >> 3); pb[i] = (float)((16 + i) >> 3); }
      const f32x32 d2 = __builtin_amdgcn_cvt_scalef32_pk32_f32_fp6(__builtin_amdgcn_cvt_scalef32_2xpk16_fp6_f32(pa, pb, 1.0f), 1.0f);
#pragma unroll
      for (int j = 0; j < 32; ++j) pi[j] = ((int)(d2[j] + 0.5f)) * 8 + (int)(d1[j] + 0.5f); }
    for (size_t i = (size_t)blockIdx.x * blockDim.x + threadIdx.x; i < n32; i += (size_t)gridDim.x * blockDim.x) {
        float4 v[8];
#pragma unroll
        for (int k = 0; k < 8; ++k) v[k] = *(const float4*)(src + i * 32 + 4 * k);
        asm volatile("s_waitcnt lgkmcnt(0)" ::: "memory");
#pragma unroll
        for (int k = 0; k < 8; ++k) { buf[pi[4 * k]] = clamp6(v[k].x * scale); buf[pi[4 * k + 1]] = clamp6(v[k].y * scale); buf[pi[4 * k + 2]] = clamp6(v[k].z * scale); buf[pi[4 * k + 3]] = clamp6(v[k].w * scale); }
        asm volatile("s_waitcnt lgkmcnt(0)" ::: "memory");
        f32x16 a, b;
#pragma unroll
        for (int k = 0; k < 16; ++k) { a[k] = buf[k]; b[k] = buf[16 + k]; }
        const u32x6 q = __builtin_amdgcn_cvt_scalef32_2xpk16_fp6_f32(a, b, 1.0f);
        u32x2* dp = (u32x2*)(dst + i * 24);
        u32x2 t; t.x = q[0]; t.y = q[1]; dp[0] = t; t.x = q[2]; t.y = q[3]; dp[1] = t; t.x = q[4]; t.y = q[5]; dp[2] = t; }
}
__device__ __forceinline__ u32x6 ld_row6(const unsigned char* rp) { const u32x2 a = *(const u32x2*)rp, b = *(const u32x2*)(rp + 8), c = *(const u32x2*)(rp + 16); u32x6 r; r[0] = a.x; r[1] = a.y; r[2] = b.x; r[3] = b.y; r[4] = c.x; r[5] = c.y; return r; }

__device__ void ph_peer_gather6(const Params& p, unsigned char* lds_) {
    constexpr int UN = 8;
    const int wid = threadIdx.x >> 6, lane = threadIdx.x & 63;
    const bf16_t* X2 = (const bf16_t*)(p.ws + OFF_X2B);
    const int* IDX = (const int*)(p.ws + OFF_IDX); const float* GG = (const float*)(p.ws + OFF_G);
    const unsigned char* UB = p.ws + OFF_UB; const unsigned char* VB = p.ws + OFF_VB;
    const float* lw = p.ln_w + 2 * DM; const float* lb = p.ln_b + 2 * DM;
    const bool lockstep = (T_TOK % (gridDim.x * 8)) == 0;
    for (int tok = blockIdx.x * 8 + wid; tok < T_TOK; tok += gridDim.x * 8) {
        int lo = lane; asm volatile("" : "+v"(lo));
        float xv[32];
#pragma unroll
        for (int k = 0; k < 4; ++k) { const u32x4 a = *(const u32x4*)(X2 + (size_t)tok * DM + 32 * lo + 8 * k);
            xv[8 * k] = bflo(a.x); xv[8 * k + 1] = bfhi(a.x); xv[8 * k + 2] = bflo(a.y); xv[8 * k + 3] = bfhi(a.y); xv[8 * k + 4] = bflo(a.z); xv[8 * k + 5] = bfhi(a.z); xv[8 * k + 6] = bflo(a.w); xv[8 * k + 7] = bfhi(a.w); }
        int idr[2]; float gr[2], ar[2] = {0.f, 0.f};
        idr[0] = IDX[(size_t)tok * 128 + lane]; idr[1] = IDX[(size_t)tok * 128 + 64 + lane];
        gr[0] = GG[(size_t)tok * 128 + lane]; gr[1] = GG[(size_t)tok * 128 + 64 + lane];
        {
            int rk0 = 0, rk1 = 0;
            const int rot = (int)(blockIdx.x & 7) * 2048;
            const int k0v = (idr[0] - rot) & 16383, k1v = (idr[1] - rot) & 16383;
#pragma unroll 4
            for (int e = 0; e < 64; ++e) { const int a = __builtin_amdgcn_readlane(k0v, e), b2 = __builtin_amdgcn_readlane(k1v, e);
                rk0 += (int)((a < k0v) || (a == k0v && e < lane)) + (int)(b2 < k0v);
                rk1 += (int)(a <= k1v) + (int)((b2 < k1v) || (b2 == k1v && e < lane)); }
            int* sidx = (int*)(lds_ + wid * 1024); float* sgv = (float*)(sidx + 128);
            asm volatile("s_waitcnt lgkmcnt(0)" ::: "memory");
            sidx[rk0] = idr[0]; sidx[rk1] = idr[1]; sgv[rk0] = gr[0]; sgv[rk1] = gr[1];
            asm volatile("s_waitcnt lgkmcnt(0)" ::: "memory");
            idr[0] = sidx[lane]; idr[1] = sidx[64 + lane]; gr[0] = sgv[lane]; gr[1] = sgv[64 + lane];
            asm volatile("s_waitcnt lgkmcnt(0)" ::: "memory");
        }
#pragma unroll
        for (int half = 0; half < 2; ++half) {
#pragma unroll 1
            for (int e = 0; e < 64; e += UN) {
                if (lockstep && (e & 15) == 0) __syncthreads();
                u32x6 r[UN];
#pragma unroll
                for (int u = 0; u < UN; ++u) { const int id = __builtin_amdgcn_readlane(idr[half], e + u); r[u] = ld_row6(UB + (size_t)id * ROW6 + 24 * lo); }
#pragma unroll
                for (int u = 0; u < UN; ++u) { const f32x32 d = __builtin_amdgcn_cvt_scalef32_pk32_f32_fp6(r[u], 1.0f); f32x2 sA = (f32x2){0.f, 0.f}, sB = (f32x2){0.f, 0.f};
#pragma unroll
                    for (int i = 0; i < 16; i += 2) {
                        sA = __builtin_elementwise_fma((f32x2){d[2 * i], d[2 * i + 1]}, (f32x2){xv[2 * i], xv[2 * i + 1]}, sA);
                        sB = __builtin_elementwise_fma((f32x2){d[2 * i + 2], d[2 * i + 3]}, (f32x2){xv[2 * i + 2], xv[2 * i + 3]}, sB); }
                    const f32x2 sS = sA + sB;
                    const float t = wsum(sS.x + sS.y);
                    if (lane == e + u) ar[half] = t * (1.0f / U6_SCALE);
                    __builtin_amdgcn_sched_barrier(0); }
            }
        }
        float hr[2];
#pragma unroll
        for (int half = 0; half < 2; ++half) hr[half] = 0.5f * ar[half] * (1.0f + erff(ar[half] * 0.70710678118654752f)) * gr[half] * (1.0f / V6_SCALE);
        float acc[32];
#pragma unroll
        for (int i = 0; i < 32; ++i) acc[i] = 0.f;
#pragma unroll
        for (int half = 0; half < 2; ++half) {
#pragma unroll 1
            for (int e = 0; e < 64; e += UN) {
                if (lockstep && (e & 15) == 0) __syncthreads();
                u32x6 r[UN]; float hv[UN];
#pragma unroll
                for (int u = 0; u < UN; ++u) { const int id = __builtin_amdgcn_readlane(idr[half], e + u); hv[u] = __int_as_float(__builtin_amdgcn_readlane(__float_as_int(hr[half]), e + u));
                    r[u] = ld_row6(VB + (size_t)id * ROW6 + 24 * lo); }
#pragma unroll
                for (int u = 0; u < UN; ++u) { const f32x32 d = __builtin_amdgcn_cvt_scalef32_pk32_f32_fp6(r[u], 1.0f); const f32x2 h2 = (f32x2){hv[u], hv[u]};
#pragma unroll
                    for (int i = 0; i < 16; ++i) { const f32x2 a2 = __builtin_elementwise_fma(h2, (f32x2){d[2 * i], d[2 * i + 1]}, (f32x2){acc[2 * i], acc[2 * i + 1]}); acc[2 * i] = a2.x; acc[2 * i + 1] = a2.y; }
                    __builtin_amdgcn_sched_barrier(0); }
            }
        }
        asm volatile("" : "+v"(lo));
        float s = 0.f;
#pragma unroll
        for (int k = 0; k < 4; ++k) { const u32x4 a = *(const u32x4*)(X2 + (size_t)tok * DM + 32 * lo + 8 * k);
            acc[8 * k] += DN_ALPHA * bflo(a.x); acc[8 * k + 1] += DN_ALPHA * bfhi(a.x); acc[8 * k + 2] += DN_ALPHA * bflo(a.y); acc[8 * k + 3] += DN_ALPHA * bfhi(a.y);
            acc[8 * k + 4] += DN_ALPHA * bflo(a.z); acc[8 * k + 5] += DN_ALPHA * bfhi(a.z); acc[8 * k + 6] += DN_ALPHA * bflo(a.w); acc[8 * k + 7] += DN_ALPHA * bfhi(a.w); }
#pragma unroll
        for (int i = 0; i < 32; ++i) s += acc[i];
        const float mean = wsum(s) * (1.0f / 2048.0f);
        float q = 0.f;
#pragma unroll
        for (int i = 0; i < 32; ++i) { acc[i] -= mean; q += acc[i] * acc[i]; }
        const float rstd = rsqrtf(wsum(q) * (1.0f / 2048.0f) + LN_EPS);
#pragma unroll
        for (int k = 0; k < 8; ++k) { const int c = 32 * lo + 4 * k;
            const float4 w0 = *(const float4*)(lw + c), b0 = *(const float4*)(lb + c);
            float4 y0;
            y0.x = acc[4 * k] * rstd * w0.x + b0.x; y0.y = acc[4 * k + 1] * rstd * w0.y + b0.y; y0.z = acc[4 * k + 2] * rstd * w0.z + b0.z; y0.w = acc[4 * k + 3] * rstd * w0.w + b0.w;
            *(float4*)(p.out + (size_t)tok * DM + c) = y0; }
    }
}

#define XB_TMO      128
#define XB_XCNT(j)  (256  + 64 * (j))
#define XB_XSUB(j)  (1280 + 64 * (j))
#define XB_XGEN(j)  (2304 + 64 * (j))
#define XB_TOP      3328
#define XB_TOPGEN   3392
#define XCD_BAR_WORDS 3456
#define XB_SPIN_CAP (1u << 18)

__device__ __forceinline__ unsigned xb_ld(unsigned* p)              { return __hip_atomic_load(p, __ATOMIC_RELAXED, __HIP_MEMORY_SCOPE_AGENT); }
__device__ __forceinline__ unsigned xb_add(unsigned* p, unsigned v) { return __hip_atomic_fetch_add(p, v, __ATOMIC_RELAXED, __HIP_MEMORY_SCOPE_AGENT); }
__device__ __forceinline__ unsigned xb_xcc_id() { return (unsigned)__builtin_amdgcn_s_getreg((3 << 11) | 20) & 0xFu; }
#define XB_SPIN(cond, bar) do { unsigned _sp = 0; while (cond) { __builtin_amdgcn_s_sleep(1); \
    if ((++_sp & 255u) == 0u) { if (xb_ld(&(bar)[XB_TMO])) break; if (_sp > XB_SPIN_CAP) { atomicAdd(&(bar)[XB_TMO], 1u); break; } } } } while (0)

struct XcdBarrier {
    unsigned* bar; unsigned x;
    volatile LAS unsigned* st;
};

__device__ __forceinline__ XcdBarrier xcd_barrier_post(unsigned* bar, volatile LAS unsigned* st) {
    XcdBarrier b; b.bar = bar; b.x = xb_xcc_id(); b.st = st;
    if (threadIdx.x == 0) (void)xb_add(&bar[XB_XCNT(b.x)], 1u);
    return b;
}
__device__ __forceinline__ void xcd_barrier_complete(unsigned* bar, unsigned x, unsigned& nloc, unsigned& nx) {
    const unsigned G = gridDim.x * gridDim.y * gridDim.z;
    unsigned sum, cnt, mine, sp = 0u;
    for (;;) {
        sum = 0u; cnt = 0u; mine = 0u;
#pragma unroll
        for (unsigned j = 0; j < 16; ++j) { const unsigned c = xb_ld(&bar[XB_XCNT(j)]); sum += c; cnt += (c > 0u) ? 1u : 0u; mine = (j == x) ? c : mine; }
        if (sum == G) break;
        __builtin_amdgcn_s_sleep(1);
        if ((++sp & 255u) == 0u) { if (xb_ld(&bar[XB_TMO])) break; if (sp > XB_SPIN_CAP) { atomicAdd(&bar[XB_TMO], 1u); break; } }
    }
    nloc = mine > 0u ? mine : 1u; nx = cnt > 0u ? cnt : 1u;
}

__device__ __forceinline__ void xcd_barrier(const XcdBarrier& b) {
    asm volatile("s_waitcnt vmcnt(0)" ::: "memory");
    __syncthreads();
    if (threadIdx.x == 0) {
        unsigned* bar = b.bar;
        __builtin_amdgcn_s_waitcnt(0);
        unsigned nloc = b.st[0], nx = b.st[1];
        if (nloc == 0u) { xcd_barrier_complete(bar, b.x, nloc, nx); b.st[0] = nloc; b.st[1] = nx; }
        const unsigned old = xb_add(&bar[XB_XSUB(b.x)], 1u);
        const unsigned gen = old / nloc;
        if (old + 1u == (gen + 1u) * nloc) {
            __builtin_amdgcn_fence(__ATOMIC_RELEASE, "agent");
            asm volatile("s_waitcnt vmcnt(0)" ::: "memory");
            const unsigned og = xb_add(&bar[XB_TOP], 1u);
            const unsigned tg = og / nx;
            if (og + 1u == (tg + 1u) * nx) xb_add(&bar[XB_TOPGEN], 1u);
            else XB_SPIN(xb_ld(&bar[XB_TOPGEN]) == tg, bar);
            __builtin_amdgcn_fence(__ATOMIC_ACQUIRE, "agent");
            xb_add(&bar[XB_XGEN(b.x)], 1u);
            asm volatile("s_waitcnt vmcnt(0)" ::: "memory");
        } else {
            XB_SPIN(xb_ld(&bar[XB_XGEN(b.x)]) == gen, bar);
            __builtin_amdgcn_fence(__ATOMIC_ACQUIRE, "agent");
            asm volatile("s_waitcnt vmcnt(0)" ::: "memory");
        }
    }
    __syncthreads();
}


__global__ void __launch_bounds__(512, 2) hybrid_fwd(Params p) {
    extern __shared__ __attribute__((aligned(16))) unsigned char lds[];
    volatile LAS unsigned* bst = (volatile LAS unsigned*)((LAS unsigned char*)lds + LDS_BYTES - 64);
    XcdBarrier xbar; xbar.bar = (unsigned*)(p.ws + OFF_CTL + 1024); xbar.x = 0; xbar.st = bst;
    if (p.coop) { if (threadIdx.x == 0) { bst[0] = 0u; bst[1] = 0u; } __syncthreads(); xbar = xcd_barrier_post((unsigned*)(p.ws + OFF_CTL + 1024), bst); }
#define GRID_SEAM(n) do { if ((n) == 1) cg::this_grid().sync(); else xcd_barrier(xbar); } while (0)
#define B16(off) ((bf16_t*)(p.ws + (off)))
#define F32(off) ((float*)(p.ws + (off)))
#ifndef REPEAT_MASK
#define REPEAT_MASK 0
#endif
#ifdef ONLY_PHASE
#define PH_COND(n) ((n) == ONLY_PHASE && p.ph_lo <= (n) && (n) < p.ph_hi)
#else
#define PH_COND(n) (p.ph_lo <= (n) && (n) < p.ph_hi)
#endif
#define PH_BEGIN(n) if (PH_COND(n)) { if ((n) > p.ph_lo && p.coop) GRID_SEAM(n); for (int rep = 0; rep < (((REPEAT_MASK >> (n)) & 1) ? 2 : 1); ++rep) { if (rep && p.coop) cg::this_grid().sync();
#define PH_END } }
    PH_BEGIN(0) {
#if !defined(P0SEL) || P0SEL == 0
            ph_prep_x(p, lds);
#endif
#if !defined(P0SEL) || P0SEL == 1
            ph_prep_w(p, lds);
#endif
#if !defined(P0SEL) || P0SEL == 2
            cvt_f32_fp8(p.mem, p.ws + OFF_MEMB, (size_t)1024 * DM / 16, XQ_SCALE);
#endif
        } PH_END
    PH_BEGIN(1) {
            pg8::EpiB16 E; E.O0 = B16(OFF_P1); E.ldc0 = P1_LD; E.O1 = B16(OFF_VT); E.ldc1 = T_TOK; E.scale = 1.0f / (XQ_SCALE * WQ_SCALE);
            pg8::run_gemm2<pg8::EpiB16, true>(lds, B16(OFF_XB), B16(OFF_WMAIN), T_TOK, P1_LD, B16(OFF_WV), B16(OFF_XB), 4096, T_TOK, E, DM / 2);
        } PH_END
    PH_BEGIN(2) ph_scans(p); ph_conv(p); PH_END
    PH_BEGIN(3) ph_mixers(p, lds, rep); PH_END
    PH_BEGIN(4) {
            { pg8::EpiB16 E; E.O0 = B16(OFF_KC); E.ldc0 = DM; E.O1 = B16(OFF_VCT); E.ldc1 = 1024; E.scale = 1.0f;
              pg8::run_gemm2<pg8::EpiB16, true>(lds, B16(OFF_MEMB), B16(OFF_WXKV), 1024, 2048, B16(OFF_WXKV) + (size_t)2048 * DM / 2, B16(OFF_MEMB), 2048, 1024, E, DM / 2, 15); }
            if (gridDim.x > 64) { if (blockIdx.x >= 64) ph_mlnorm(p, blockIdx.x - 64, gridDim.x - 64); } else ph_mlnorm(p, blockIdx.x, gridDim.x);
        } PH_END
    PH_BEGIN(5) {
            pg8::EpiBr E; E.T1 = B16(OFF_T1); E.gate0 = B16(OFF_P1) + 8192; E.gate1 = B16(OFF_P1) + 10240; E.ldg = P1_LD; E.O = B16(OFF_MRG);
            pg8::run_gemm2<pg8::EpiBr, true>(lds, B16(OFF_HB), B16(OFF_WSQ), T_TOK, DM, B16(OFF_YB), B16(OFF_WSQ + 8 * MiB), T_TOK, DM, E, DM / 2);
        } PH_END
    PH_BEGIN(6) { pg8::EpiResB<false> E; E.C = B16(OFF_PRE); E.R = p.x; E.alpha = DN_ALPHA; pg8::run_gemm2<pg8::EpiResB<false>, true>(lds, B16(OFF_MRG), B16(OFF_WSQ + 16 * MiB), T_TOK, DM, nullptr, nullptr, 0, 0, E, DM / 2, 16); } PH_END
    PH_BEGIN(7) {
            ph_ln_rows(B16(OFF_PRE), p.ln_w, p.ln_b, B16(OFF_X1B), p.ws + OFF_X1Q);
            __syncthreads(); cvt_f32_fp6(p.peer_u, p.ws + OFF_UB, (size_t)16384 * DM / 32, U6_SCALE, lds); cvt_f32_fp6(p.peer_v, p.ws + OFF_VB, (size_t)16384 * DM / 32, V6_SCALE, lds);
        } PH_END
    PH_BEGIN(8) { pg8::EpiB16 E; E.O0 = B16(OFF_QX); E.ldc0 = DM; E.O1 = nullptr; E.ldc1 = 0; E.scale = 1.0f; pg8::run_gemm2<pg8::EpiB16, true>(lds, B16(OFF_X1Q), B16(OFF_WSQ + 24 * MiB), T_TOK, DM, nullptr, nullptr, 0, 0, E, DM / 2); } PH_END
    PH_BEGIN(9) { for (int it = blockIdx.x; it < 256; it += gridDim.x) xattn_item(p, lds, it >> 6, (it >> 4) & 3, it & 15); } PH_END
    PH_BEGIN(10) { pg8::EpiResB<true> E; E.C = B16(OFF_PRE); E.R = B16(OFF_X1B); E.alpha = DN_ALPHA; pg8::run_gemm2<pg8::EpiResB<true>, true>(lds, B16(OFF_OB), B16(OFF_WSQ + 32 * MiB), T_TOK, DM, nullptr, nullptr, 0, 0, E, DM / 2, 17); } PH_END
    PH_BEGIN(11) ph_ln_rows(B16(OFF_PRE), p.ln_w + DM, p.ln_b + DM, B16(OFF_X2B), nullptr); PH_END
    PH_BEGIN(12) { pg8::EpiRes E; E.C = F32(OFF_QP); E.R = nullptr; E.alpha = 0.f; pg8::run_gemm2(lds, B16(OFF_X2B), B16(OFF_WSQ + 40 * MiB), T_TOK, DM, nullptr, nullptr, 0, 0, E); } PH_END
    PH_BEGIN(13) ph_peer_score(p, lds); PH_END
    PH_BEGIN(14) ph_peer_gather6(p, lds); PH_END
}

extern "C" void kernel_launch(void* const* d_in, const int* in_sizes, int n_in, void* d_out, int out_size, void* d_ws, size_t ws_size, hipStream_t stream) {
    static int grid = 0;
    if (grid == 0) {
        if (ws_size < WS_END) { fprintf(stderr, "kernel_launch: workspace too small (%zu < %zu)\n", ws_size, (size_t)WS_END); grid = -1; return; }
        int dev = 0, cus = 0, per_cu = 0;
        hipGetDevice(&dev); hipDeviceGetAttribute(&cus, hipDeviceAttributeMultiprocessorCount, dev);
        hipFuncSetAttribute((const void*)hybrid_fwd, hipFuncAttributeMaxDynamicSharedMemorySize, LDS_BYTES);
        hipOccupancyMaxActiveBlocksPerMultiprocessor(&per_cu, (const void*)hybrid_fwd, 512, LDS_BYTES);
        if (per_cu < 1) per_cu = 1;
        (void)hipGetLastError();
        grid = cus * per_cu;
    }
    if (grid < 0) return;
    hipMemsetAsync((char*)d_ws + OFF_CTL, 0, 32768, stream);
    Params p{};
    p.x = (const float*)d_in[0]; p.mem = (const float*)d_in[1]; p.w_in = (const float*)d_in[2]; p.conv_w = (const float*)d_in[3]; p.conv_b = (const float*)d_in[4];
    p.gate_b = (const float*)d_in[5]; p.norm_w = (const float*)d_in[6]; p.fox_f_b = (const float*)d_in[7];
    p.w_sq[0] = (const float*)d_in[8]; p.w_sq[1] = (const float*)d_in[9]; p.w_sq[2] = (const float*)d_in[10]; p.w_sq[3] = (const float*)d_in[11];
    p.w_xkv = (const float*)d_in[12]; p.w_sq[4] = (const float*)d_in[13]; p.w_sq[5] = (const float*)d_in[14];
    p.sub_keys = (const float*)d_in[15]; p.peer_u = (const float*)d_in[16]; p.peer_v = (const float*)d_in[17]; p.ln_w = (const float*)d_in[18]; p.ln_b = (const float*)d_in[19];
    p.out = (float*)d_out; p.ws = (unsigned char*)d_ws;
#ifndef ONE_LAUNCH
#define ONE_LAUNCH 1
#endif
    if (ONE_LAUNCH) {
        p.ph_lo = 0; p.ph_hi = NPHASE + 1; p.coop = 1;
        void* args[] = {&p};
        hipError_t e = hipLaunchCooperativeKernel((const void*)hybrid_fwd, dim3(grid), dim3(512), args, LDS_BYTES, stream);
        if (e != hipSuccess) fprintf(stderr, "cooperative launch failed: %s (grid %d)\n", hipGetErrorString(e), grid);
    } else {
        for (int ph = 0; ph <= NPHASE; ++ph) { p.ph_lo = ph; p.ph_hi = ph + 1; p.coop = 0;
            hipLaunchKernelGGL(hybrid_fwd, dim3(grid), dim3(512), LDS_BYTES, stream, p); }
    }
}
```
